# Optimizing an MI355X kernel written in HIP

```python
import math
import jax, jax.numpy as jnp
from jax import lax
import numpy as np

D_MODEL = 2048
BATCH = 1
SEQ = 8192
DEPTH = 2

GRID_W = 64
CTX_LEN = 256
D_MIX = D_MODEL
D_S5 = D_MIX // 2
D_CONV = D_MIX - D_S5
S5_GROUP = 16
S5_GROUPS = D_S5 // S5_GROUP
S5_STATE = 64
N_DIR = 2
CONV_WIDTH = 3
D_IN = 2 * D_S5 + 4 * D_CONV
DEEPNORM_ALPHA = (2.0 * DEPTH) ** 0.25
DEEPNORM_BETA = (8.0 * DEPTH) ** -0.25
LN_EPS = 1e-6
DT_MIN = 1e-3
DT_MAX = 1e-1

kernel_name = 'hybrid_s5_shortconv_deepnorm_dit'


def _layernorm(v):
    v32 = v.astype(jnp.float32)
    mu = jnp.mean(v32, axis=-1, keepdims=True)
    var = jnp.mean(jnp.square(v32 - mu), axis=-1, keepdims=True)
    return (v32 - mu) * lax.rsqrt(var + LN_EPS)


def _adaln(cond, w_ada, b_ada):
    mod = jax.nn.silu(cond) @ w_ada + b_ada
    return mod[..., :D_MODEL], mod[..., D_MODEL:2 * D_MODEL], mod[..., 2 * D_MODEL:]


def _modulate(v, shift, scale):
    return (_layernorm(v) * (1.0 + scale) + shift).astype(v.dtype)


def _split_proj(p):
    o1, o2, o3, o4, o5 = D_S5, 2 * D_S5, 2 * D_S5 + D_CONV, 2 * D_S5 + 2 * D_CONV, 2 * D_S5 + 3 * D_CONV
    return p[..., :o1], p[..., o1:o2], p[..., o2:o3], p[..., o3:o4], p[..., o4:o5], p[..., o5:]


def _s5_discretize(a_re, a_im, log_dt, b_re, b_im):
    lam = lax.complex(a_re.astype(jnp.float32), a_im.astype(jnp.float32))
    dt = jnp.exp(log_dt.astype(jnp.float32))[:, None]
    a_bar = jnp.exp(lam * dt)
    b = lax.complex(b_re.astype(jnp.float32), b_im.astype(jnp.float32))
    b_bar = ((a_bar - 1.0) / lam)[..., None] * b
    return a_bar, b_bar


def _scan_op(e1, e2):
    a1, b1 = e1
    a2, b2 = e2
    return a2 * a1, a2 * b1 + b2


def _s5_scan(a_bar, b_bar, u, h0, reverse):
    bu = jnp.einsum('gph,bngh->bngp', b_bar, u.astype(jnp.complex64))
    if h0 is not None:
        edge = -1 if reverse else 0
        bu = bu.at[:, edge].add(a_bar * h0)
    a = jnp.broadcast_to(a_bar, bu.shape)
    _, states = lax.associative_scan(_scan_op, (a, bu), axis=1, reverse=reverse)
    return states


def _s5_glu(y, w_glu, b_glu):
    g = jax.nn.gelu(y)
    return g * jax.nn.sigmoid(g @ w_glu.astype(jnp.float32) + b_glu.astype(jnp.float32))


def _s5_mixer(u_lat, u_ctx, a_re, a_im, log_dt, b_re, b_im, c_re, c_im, d_skip, w_glu, b_glu, with_ctx_out):
    bsz, n_lat, _ = u_lat.shape
    n_ctx = u_ctx.shape[1]
    ul = u_lat.astype(jnp.float32).reshape(bsz, n_lat, S5_GROUPS, S5_GROUP)
    uc = u_ctx.astype(jnp.float32).reshape(bsz, n_ctx, S5_GROUPS, S5_GROUP)
    d_g = d_skip.astype(jnp.float32).reshape(S5_GROUPS, S5_GROUP)
    y_lat = ul * d_g
    y_ctx = uc * d_g
    for d in range(N_DIR):
        reverse = d == 1
        a_bar, b_bar = _s5_discretize(a_re[d], a_im[d], log_dt[d], b_re[d], b_im[d])
        c_mat = lax.complex(c_re[d].astype(jnp.float32), c_im[d].astype(jnp.float32))
        h_ctx = _s5_scan(a_bar, b_bar, uc, None, reverse)
        h_last = h_ctx[:, 0] if reverse else h_ctx[:, -1]
        h_lat = _s5_scan(a_bar, b_bar, ul, h_last, reverse)
        y_lat = y_lat + jnp.einsum('ghp,bngp->bngh', c_mat, h_lat).real
        if with_ctx_out:
            y_ctx = y_ctx + jnp.einsum('ghp,bngp->bngh', c_mat, h_ctx).real
    out_lat = _s5_glu(y_lat.reshape(bsz, n_lat, D_S5), w_glu, b_glu)
    if not with_ctx_out:
        return out_lat, None
    return out_lat, _s5_glu(y_ctx.reshape(bsz, n_ctx, D_S5), w_glu, b_glu)


def _dwconv3(v, w, b):
    vp = jnp.pad(v, [(0, 0)] * (v.ndim - 2) + [(1, 1), (0, 0)])
    return vp[..., :-2, :] * w[0] + vp[..., 1:-1, :] * w[1] + vp[..., 2:, :] * w[2] + b


def _conv_branch(v, bg, cg, conv_w, conv_b, rows):
    s = cg * v
    if rows is None:
        conv = _dwconv3(s, conv_w, conv_b)
    else:
        bsz, n, ch = s.shape
        conv = _dwconv3(s.reshape(bsz, rows, GRID_W, ch), conv_w, conv_b).reshape(bsz, n, ch)
    return bg * conv


def _merge_out(y_s5, z_s5, y_cv, z_cv, w_out):
    o = jnp.concatenate([y_s5 * jax.nn.silu(z_s5), y_cv * jax.nn.silu(z_cv)], axis=-1)
    return o @ w_out


def _post_norm(res, sub, gate, ln_g, ln_b):
    v = DEEPNORM_ALPHA * res.astype(jnp.float32) + gate * sub.astype(jnp.float32)
    return (_layernorm(v) * ln_g + ln_b).astype(res.dtype)


def _layer(x, ctx, c, c_ctx, w_ada, b_ada, w_in, a_re, a_im, log_dt, b_re, b_im, c_re, c_im,
           d_skip, w_glu, b_glu, conv_w, conv_b, w_out, ln_g, ln_b, update_ctx):
    n_lat = x.shape[1]
    rows = n_lat // GRID_W
    shift, scale, gate = _adaln(c, w_ada, b_ada)
    shift_c, scale_c, gate_c = _adaln(c_ctx, w_ada, b_ada)
    h = _modulate(x, shift[:, None], scale[:, None])
    hc = _modulate(ctx, shift_c, scale_c)
    u, z_s5, v, bg, cg, z_cv = _split_proj(h @ w_in)
    if update_ctx:
        u_c, z_s5_c, v_c, bg_c, cg_c, z_cv_c = _split_proj(hc @ w_in)
    else:
        u_c = hc @ w_in[:, :D_S5]
    y_s5, y_s5_c = _s5_mixer(u, u_c, a_re, a_im, log_dt, b_re, b_im, c_re, c_im,
                             d_skip, w_glu, b_glu, update_ctx)
    y_cv = _conv_branch(v, bg, cg, conv_w, conv_b, rows)
    x_new = _post_norm(x, _merge_out(y_s5, z_s5, y_cv, z_cv, w_out), gate[:, None], ln_g, ln_b)
    if not update_ctx:
        return x_new, ctx
    y_cv_c = _conv_branch(v_c, bg_c, cg_c, conv_w, conv_b, None)
    ctx_new = _post_norm(ctx, _merge_out(y_s5_c, z_s5_c, y_cv_c, z_cv_c, w_out), gate_c, ln_g, ln_b)
    return x_new, ctx_new


def setup_inputs(seed: int = 0) -> dict:
    key = jax.random.key(seed)
    ks = jax.random.split(key, 24)
    f32 = jnp.float32

    def nrm(k, shape, s):
        return s * jax.random.normal(k, shape, f32)

    s5_a = (DEPTH, N_DIR, S5_GROUPS, S5_STATE)
    s5_b = (DEPTH, N_DIR, S5_GROUPS, S5_STATE, S5_GROUP)
    s5_c = (DEPTH, N_DIR, S5_GROUPS, S5_GROUP, S5_STATE)
    n_idx = jnp.arange(S5_STATE, dtype=f32)
    return {
        'x': nrm(ks[0], (BATCH, SEQ, D_MODEL), 1.0),
        'c': nrm(ks[1], (BATCH, D_MODEL), 1.0),
        'ctx': nrm(ks[2], (BATCH, CTX_LEN, D_MODEL), 1.0),
        'c_ctx': nrm(ks[3], (D_MODEL,), 1.0),
        'w_ada': nrm(ks[4], (DEPTH, D_MODEL, 3 * D_MODEL), 0.5 * D_MODEL ** -0.5),
        'b_ada': nrm(ks[5], (DEPTH, 3 * D_MODEL), 0.02),
        'w_in': nrm(ks[6], (DEPTH, D_MODEL, D_IN), D_MODEL ** -0.5),
        's5_a_re': -0.5 + nrm(ks[7], s5_a, 0.01),
        's5_a_im': math.pi * n_idx + nrm(ks[8], s5_a, 0.01),
        's5_log_dt': jax.random.uniform(ks[9], (DEPTH, N_DIR, S5_GROUPS), f32,
                                        math.log(DT_MIN), math.log(DT_MAX)),
        's5_b_re': nrm(ks[10], s5_b, (2 * S5_GROUP) ** -0.5),
        's5_b_im': nrm(ks[11], s5_b, (2 * S5_GROUP) ** -0.5),
        's5_c_re': nrm(ks[12], s5_c, S5_STATE ** -0.5),
        's5_c_im': nrm(ks[13], s5_c, S5_STATE ** -0.5),
        's5_d': nrm(ks[14], (DEPTH, D_S5), 1.0),
        'w_glu': nrm(ks[15], (DEPTH, D_S5, D_S5), D_S5 ** -0.5),
        'b_glu': nrm(ks[16], (DEPTH, D_S5), 0.02),
        'conv_w': nrm(ks[17], (DEPTH, CONV_WIDTH, D_CONV), CONV_WIDTH ** -0.5),
        'conv_b': nrm(ks[18], (DEPTH, D_CONV), 0.02),
        'w_out': nrm(ks[19], (DEPTH, D_MIX, D_MODEL), DEEPNORM_BETA * D_MIX ** -0.5),
        'ln_g': 1.0 + nrm(ks[20], (DEPTH, D_MODEL), 0.02),
        'ln_b': nrm(ks[21], (DEPTH, D_MODEL), 0.02),
    }


def reference(x, c, ctx, c_ctx, w_ada, b_ada, w_in, s5_a_re, s5_a_im, s5_log_dt, s5_b_re, s5_b_im,
              s5_c_re, s5_c_im, s5_d, w_glu, b_glu, conv_w, conv_b, w_out, ln_g, ln_b):
    for i in range(DEPTH):
        x, ctx = _layer(x, ctx, c, c_ctx, w_ada[i], b_ada[i], w_in[i], s5_a_re[i], s5_a_im[i],
                        s5_log_dt[i], s5_b_re[i], s5_b_im[i], s5_c_re[i], s5_c_im[i], s5_d[i],
                        w_glu[i], b_glu[i], conv_w[i], conv_b[i], w_out[i], ln_g[i], ln_b[i],
                        i < DEPTH - 1)
    return x
```

```cpp
#include <hip/hip_runtime.h>
#include <hip/hip_cooperative_groups.h>
#include <cstdio>
namespace cg = cooperative_groups;

#ifndef N_LAUNCH_SPLIT
#define N_LAUNCH_SPLIT 0
#endif

#define LAS __attribute__((address_space(3)))
typedef _Float16 f16;
typedef _Float16 h8 __attribute__((ext_vector_type(8)));
typedef _Float16 h4 __attribute__((ext_vector_type(4)));
typedef _Float16 h2 __attribute__((ext_vector_type(2)));
typedef float f32x4 __attribute__((ext_vector_type(4)));
typedef float f32x2 __attribute__((ext_vector_type(2)));

constexpr int D = 2048, NCTX = 256, NLAT = 8192, NTOK = 8448, DIN = 6144, DS5 = 1024;
constexpr int NCH = 132;
constexpr int NTHR = 512;
constexpr float ALPHA = 1.4142135623730951f;
constexpr float LN_EPS = 1e-6f;

constexpr size_t WS_CTL = 0;
constexpr size_t WS_MOD = 4096;
constexpr size_t WS_ABAR = WS_MOD + 98304;
constexpr size_t WS_APOW = WS_ABAR + 131072;
constexpr size_t WS_BMAT = WS_APOW + 131072;
constexpr size_t WS_CMAT = WS_BMAT + 1048576;
constexpr size_t WS_EST = WS_CMAT + 1048576;
constexpr size_t WS_SCAR = WS_EST + 8650752;
constexpr size_t WS_CTXV = WS_SCAR + 8650752;
constexpr size_t WS_CTXN = WS_CTXV + 2097152;
constexpr size_t WS_WIN = WS_CTXN + 2097152;
constexpr size_t WS_WOUT = WS_WIN + 50331648;
constexpr size_t WS_WGLU = WS_WOUT + 16777216;
constexpr size_t WS_AO = WS_WGLU + 4194304;
constexpr size_t WS_P = WS_AO + 34603008;
constexpr size_t WS_G = WS_P + 103809024;
constexpr size_t WS_END = WS_G + 17301504;

constexpr int LDS_BYTES = 139264;

struct Params {
    const float *x, *c, *ctx, *cctx, *w_ada, *b_ada, *w_in, *a_re, *a_im, *log_dt, *b_re, *b_im, *c_re, *c_im, *s5_d, *w_glu, *b_glu,
        *conv_w, *conv_b, *w_out, *ln_g, *ln_b;
    float* out; unsigned char* ws; int ph_lo, ph_hi;
};

__device__ __forceinline__ float silu_f(float v) { return v / (1.0f + __expf(-v)); }
__device__ __forceinline__ float sigmoid_f(float v) { return 1.0f / (1.0f + __expf(-v)); }
__device__ __forceinline__ float gelu_tanh_f(float v) {
    const float z = 0.7978845608028654f * (v + 0.044715f * v * v * v);
    const float th = 1.0f - 2.0f / (__expf(2.0f * z) + 1.0f);
    return 0.5f * v * (1.0f + th);
}
__device__ __forceinline__ float wave_sum(float v) {
#pragma unroll
    for (int o = 32; o >= 1; o >>= 1) v += __shfl_xor(v, o);
    return v;
}

namespace pg8 {
constexpr int BM = 256, BK = 64, HALF = 128, HTB = HALF * BK * 2, STAGE_BYTES = 8 * HTB, NXCD = 8, WGM = 8;
__device__ __forceinline__ int lds_byte(int r, int c) { const int st = (r >> 4) * 2 + (c >> 5), rr = r & 15, cc = c & 31, ob = rr * 64 + cc * 2; return st * 1024 + (ob ^ (((ob >> 9) & 1) << 5)); }
__device__ __forceinline__ void stage_rc(int b, int& R, int& C) { const int st = b / 1024, sb = b % 1024, swz = sb ^ (((sb >> 9) & 1) << 5); R = (st >> 1) * 16 + swz / 64; C = (st & 1) * 32 + (swz % 64) / 2; }
__device__ __forceinline__ int perm32(int rho) { const int n = rho >> 4, i = rho & 15; return 8 * (i >> 2) + 4 * n + (i & 3); }
struct Unit { int pm, pn; };
struct Gemm { const f16* A; const f16* Bt; int M, N, K; };
struct StaticOrder {
    int nM, nN, nwg, G, c, pm0;
    __device__ void init(int M, int N, int G_, int c_, int pm0_) { nM = M / BM; nN = N / BM; nwg = nM * nN; G = G_; c = c_; pm0 = pm0_; }
    __device__ bool next(int i, Unit& u) const {
        const long L = (long)i * G + c; if (L >= nwg) return false;
        int wgid = (int)L; { const int q = nwg / NXCD, r = nwg % NXCD, xcd = wgid % NXCD, off = wgid / NXCD; wgid = (xcd < r ? xcd * (q + 1) : r * (q + 1) + (xcd - r) * q) + off; }
        const int nig = WGM * nN, gid = wgid / nig, fm = gid * WGM, gsz = (nM - fm) < WGM ? (nM - fm) : WGM;
        u.pm = pm0 + fm + ((wgid % nig) % gsz); u.pn = (wgid % nig) / gsz; return true;
    }
};

template <class Epi>
__device__ __forceinline__ void gemm_phase(LAS unsigned char* lds, const Gemm g, const StaticOrder& S, const Epi& E) {
    int tid = threadIdx.x; asm volatile("" : "+v"(tid));
    const int wid = __builtin_amdgcn_readfirstlane(tid >> 6), lane = tid & 63, wr = wid >> 2, wc = wid & 3, fr = lane & 15, fq = lane >> 4;
    const int K = g.K, nt = K / BK;
    unsigned voffA[2], voffB[2];
#pragma unroll
    for (int i = 0; i < 2; ++i) { int R, C; stage_rc(tid * 16 + i * 8192, R, C); const int Rb = Epi::PERM ? ((R & ~31) + perm32(R & 31)) : R;
        voffA[i] = (unsigned)(R * K + C) * 2u; voffB[i] = (unsigned)(Rb * K + C) * 2u; }
    const size_t kstep = (size_t)(BK * 2);
    const size_t hstep = (size_t)HALF * K * 2;
    const size_t tstep = 2 * hstep;
    const unsigned ldsw = (unsigned)wid * 1024u;
    const int aoff = lds_byte(wr * 64 + fr, fq * 8), boff = lds_byte(wc * 32 + fr, fq * 8);
#define PG8_SA(b, h) (((b) * 2 + (h)) * HTB)
#define PG8_SB(b, h) ((4 + (b) * 2 + (h)) * HTB)
#define PG8_STAGE(bufoff, gbase, voff) do { _Pragma("unroll") for (int _i = 0; _i < 2; ++_i) \
        __builtin_amdgcn_global_load_lds((const unsigned*)((const char*)(gbase) + (voff)[_i]), (LAS unsigned*)(lds + (bufoff) + ldsw + _i * 8192), 16, 0, 0); } while (0)
#define PG8_LDA(dst, b, h) do { _Pragma("unroll") for (int m = 0; m < 4; ++m) _Pragma("unroll") for (int k = 0; k < 2; ++k) dst[m][k] = *(const LAS h8*)(lds + PG8_SA(b, h) + aoff + m * 2048 + k * 1024); } while (0)
#define PG8_LDB(dst, b, h) do { _Pragma("unroll") for (int n = 0; n < 2; ++n) _Pragma("unroll") for (int k = 0; k < 2; ++k) dst[n][k] = *(const LAS h8*)(lds + PG8_SB(b, h) + boff + n * 2048 + k * 1024); } while (0)
#define PG8_MMA(ai, bj, At, Bt) do { __builtin_amdgcn_s_setprio(1); _Pragma("unroll") for (int m = 0; m < 4; ++m) _Pragma("unroll") for (int n = 0; n < 2; ++n) _Pragma("unroll") for (int k = 0; k < 2; ++k) \
        acc[ai][bj][m][n] = __builtin_amdgcn_mfma_f32_16x16x32_f16(Bt[n][k], At[m][k], acc[ai][bj][m][n], 0, 0, 0); __builtin_amdgcn_s_setprio(0); } while (0)
#define PG8_WAIT_V(n) asm volatile("s_waitcnt vmcnt(" #n ")" ::: "memory")
#define PG8_WAIT_L(n) asm volatile("s_waitcnt lgkmcnt(" #n ")" ::: "memory")
#define PG8_BAR __builtin_amdgcn_s_barrier()
#define PG8_SCHED __builtin_amdgcn_sched_barrier(0)
    Unit cur, nxt; int ui = 0;
    if (!S.next(0, cur)) return;
    f32x4 acc[2][2][4][2];
#pragma unroll
    for (int a = 0; a < 2; ++a)
#pragma unroll
        for (int b = 0; b < 2; ++b)
#pragma unroll
            for (int m = 0; m < 4; ++m)
#pragma unroll
                for (int n = 0; n < 2; ++n) acc[a][b][m][n] = (f32x4){0.f, 0.f, 0.f, 0.f};
    h8 At[4][2], B0[2][2], B1[2][2];
    const char* cA = (const char*)g.A + (size_t)cur.pm * tstep; const char* cB = (const char*)g.Bt + (size_t)cur.pn * tstep;
    PG8_STAGE(PG8_SB(0, 0), cB, voffB); PG8_STAGE(PG8_SA(0, 0), cA, voffA); PG8_STAGE(PG8_SB(0, 1), cB + hstep, voffB); PG8_STAGE(PG8_SA(0, 1), cA + hstep, voffA);
    if (wr == 1) PG8_BAR;
    PG8_WAIT_V(4); PG8_BAR;
    PG8_STAGE(PG8_SB(1, 0), cB + kstep, voffB); PG8_STAGE(PG8_SA(1, 0), cA + kstep, voffA); PG8_STAGE(PG8_SB(1, 1), cB + hstep + kstep, voffB);
    PG8_WAIT_V(6); PG8_BAR;
    for (;;) {
        const bool has_next = S.next(ui + 1, nxt);
        const char* nA = has_next ? (const char*)g.A + (size_t)nxt.pm * tstep : cA; const char* nB = has_next ? (const char*)g.Bt + (size_t)nxt.pn * tstep : cB;
        for (int t = 0; t < nt; t += 2) {
            const bool last = (t == nt - 2);
            const char* a1 = cA + (size_t)(t + 1) * kstep;
            const char* a2 = last ? nA : cA + (size_t)(t + 2) * kstep; const char* b2 = last ? nB : cB + (size_t)(t + 2) * kstep;
            const char* a3 = a2 + kstep; const char* b3 = b2 + kstep;
            PG8_LDB(B0, 0, 0); PG8_SCHED; PG8_LDA(At, 0, 0); PG8_STAGE(PG8_SA(1, 1), a1 + hstep, voffA);
            PG8_WAIT_L(8); PG8_BAR; PG8_WAIT_L(0); PG8_MMA(0, 0, At, B0); PG8_BAR; PG8_SCHED;
            PG8_LDB(B1, 0, 1); PG8_STAGE(PG8_SB(0, 0), b2, voffB);
            PG8_BAR; PG8_WAIT_L(0); PG8_MMA(0, 1, At, B1); PG8_BAR;
            PG8_LDA(At, 0, 1); PG8_STAGE(PG8_SA(0, 0), a2, voffA);
            PG8_BAR; PG8_WAIT_L(0); PG8_MMA(1, 0, At, B0); PG8_BAR; PG8_SCHED;
            PG8_STAGE(PG8_SB(0, 1), b2 + hstep, voffB);
            PG8_WAIT_V(6); PG8_BAR; PG8_MMA(1, 1, At, B1); PG8_BAR;
            PG8_LDB(B0, 1, 0); PG8_SCHED; PG8_LDA(At, 1, 0); PG8_STAGE(PG8_SA(0, 1), a2 + hstep, voffA);
            PG8_WAIT_L(8); PG8_BAR; PG8_WAIT_L(0); PG8_MMA(0, 0, At, B0); PG8_BAR; PG8_SCHED;
            PG8_LDB(B1, 1, 1); PG8_STAGE(PG8_SB(1, 0), b3, voffB);
            PG8_BAR; PG8_WAIT_L(0); PG8_MMA(0, 1, At, B1); PG8_BAR;
            PG8_LDA(At, 1, 1); PG8_STAGE(PG8_SA(1, 0), a3, voffA);
            PG8_BAR; PG8_WAIT_L(0); PG8_MMA(1, 0, At, B0); PG8_BAR; PG8_SCHED;
            PG8_STAGE(PG8_SB(1, 1), b3 + hstep, voffB);
            PG8_WAIT_V(6); PG8_BAR; PG8_MMA(1, 1, At, B1); PG8_BAR;
        }
        E(acc, cur, wr, wc, fr, fq);
        if (!has_next) break;
#pragma unroll
        for (int a = 0; a < 2; ++a)
#pragma unroll
            for (int b = 0; b < 2; ++b)
#pragma unroll
                for (int m = 0; m < 4; ++m)
#pragma unroll
                    for (int n = 0; n < 2; ++n) acc[a][b][m][n] = (f32x4){0.f, 0.f, 0.f, 0.f};
        cur = nxt; cA = nA; cB = nB; ++ui;
    }
    PG8_WAIT_V(0);
    if (wr == 0) PG8_BAR;
    PG8_BAR;
#undef PG8_SA
#undef PG8_SB
#undef PG8_STAGE
#undef PG8_LDA
#undef PG8_LDB
#undef PG8_MMA
#undef PG8_WAIT_V
#undef PG8_WAIT_L
#undef PG8_BAR
#undef PG8_SCHED
}
}

__device__ __forceinline__ h8 pack8(const f32x4 a, const f32x4 b) {
    h8 r; r[0] = (f16)a[0]; r[1] = (f16)a[1]; r[2] = (f16)a[2]; r[3] = (f16)a[3]; r[4] = (f16)b[0]; r[5] = (f16)b[1]; r[6] = (f16)b[2]; r[7] = (f16)b[3]; return r;
}

struct EpiP {
    static constexpr bool PERM = true;
    f16* P;
    __device__ __forceinline__ void operator()(const f32x4 (&acc)[2][2][4][2], const pg8::Unit& u, int wr, int wc, int fr, int fq) const {
        const int row0 = u.pm * 256 + wr * 64 + fr, col0 = u.pn * 256 + wc * 32 + 8 * fq;
#pragma unroll
        for (int ai = 0; ai < 2; ++ai)
#pragma unroll
            for (int m = 0; m < 4; ++m) { f16* rowp = P + (size_t)(row0 + ai * 128 + m * 16) * DIN + col0;
#pragma unroll
                for (int bj = 0; bj < 2; ++bj) *(h8*)(rowp + bj * 128) = pack8(acc[ai][bj][m][0], acc[ai][bj][m][1]); }
    }
};
struct EpiGlu {
    static constexpr bool PERM = true;
    const f16* G; const f16* P; const float* bglu; f16* O;
    __device__ __forceinline__ void operator()(const f32x4 (&acc)[2][2][4][2], const pg8::Unit& u, int wr, int wc, int fr, int fq) const {
        const int row0 = u.pm * 256 + wr * 64 + fr, col0 = u.pn * 256 + wc * 32 + 8 * fq;
        f32x4 bv[2][2];
#pragma unroll
        for (int bj = 0; bj < 2; ++bj) { bv[bj][0] = *(const f32x4*)(bglu + col0 + bj * 128); bv[bj][1] = *(const f32x4*)(bglu + col0 + bj * 128 + 4); }
#pragma unroll
        for (int ai = 0; ai < 2; ++ai)
#pragma unroll
            for (int m = 0; m < 4; ++m) { const size_t row = (size_t)(row0 + ai * 128 + m * 16);
#pragma unroll
                for (int bj = 0; bj < 2; ++bj) { const int col = col0 + bj * 128;
                    const h8 gv = *(const h8*)(G + row * DS5 + col); const h8 zv = *(const h8*)(P + row * DIN + DS5 + col);
                    h8 o;
#pragma unroll
                    for (int j = 0; j < 8; ++j) { const float t = acc[ai][bj][m][j >> 2][j & 3] + bv[bj][j >> 2][j & 3]; const float z = (float)zv[j];
                        o[j] = (f16)((float)gv[j] * sigmoid_f(t) * silu_f(z)); }
                    *(h8*)(O + row * D + col) = o; } }
    }
};
struct EpiOut {
    static constexpr bool PERM = false;
    const float* xres_lat; const float* xres_ctx; float* v_lat; float* v_ctx; const float* gate_lat; const float* gate_ctx;
    __device__ __forceinline__ void operator()(const f32x4 (&acc)[2][2][4][2], const pg8::Unit& u, int wr, int wc, int fr, int fq) const {
        const bool isctx = (u.pm == 0);
        const float* xr = isctx ? xres_ctx : xres_lat - (size_t)NCTX * D; float* vo = isctx ? v_ctx : v_lat - (size_t)NCTX * D; const float* gt = isctx ? gate_ctx : gate_lat;
        const int row0 = u.pm * 256 + wr * 64 + fr, col0 = u.pn * 256 + wc * 32 + 4 * fq;
        f32x4 gv[2][2];
#pragma unroll
        for (int bj = 0; bj < 2; ++bj)
#pragma unroll
            for (int n = 0; n < 2; ++n) gv[bj][n] = *(const f32x4*)(gt + col0 + bj * 128 + n * 16);
#pragma unroll
        for (int ai = 0; ai < 2; ++ai)
#pragma unroll
            for (int m = 0; m < 4; ++m) { const size_t off = (size_t)(row0 + ai * 128 + m * 16) * D + col0;
#pragma unroll
                for (int bj = 0; bj < 2; ++bj)
#pragma unroll
                    for (int n = 0; n < 2; ++n) { const f32x4 xv = *(const f32x4*)(xr + off + bj * 128 + n * 16);
                        *(f32x4*)(vo + off + bj * 128 + n * 16) = ALPHA * xv + gv[bj][n] * acc[ai][bj][m][n]; } }
    }
};

__device__ void transpose_tile(const float* src, int N, f16* dst, int K, int tk, int tn, LAS float* tile) {
    int tid = threadIdx.x; asm volatile("" : "+v"(tid));
    { const int r = tid >> 4, c4 = tid & 15;
#pragma unroll
        for (int h = 0; h < 2; ++h) { const int k = r + 32 * h; const f32x4 v = *(const f32x4*)(src + (size_t)(tk * 64 + k) * N + tn * 64 + 4 * c4);
            tile[k * 65 + 4 * c4 + 0] = v[0]; tile[k * 65 + 4 * c4 + 1] = v[1]; tile[k * 65 + 4 * c4 + 2] = v[2]; tile[k * 65 + 4 * c4 + 3] = v[3]; } }
    __syncthreads();
    { const int n = tid >> 3, k8 = (tid & 7) * 8; h8 o;
#pragma unroll
        for (int j = 0; j < 8; ++j) o[j] = (f16)tile[(k8 + j) * 65 + n];
        *(h8*)(dst + (size_t)(tn * 64 + n) * K + tk * 64 + k8) = o; }
    __syncthreads();
}

__device__ void phase_prologue(const Params& p, LAS unsigned char* lds) {
    int tid = threadIdx.x; asm volatile("" : "+v"(tid));
    const int wid = __builtin_amdgcn_readfirstlane(tid >> 6), lane = tid & 63;
    unsigned char* ws = p.ws;
    const int total = 128 + 8704;
    for (int it = blockIdx.x; it < total; it += gridDim.x) {
        if (it < 96) {
            const int layer = it / 48, n0 = (it % 48) * 128;
            LAS float* sc = (LAS float*)lds;
            LAS float* red = sc + 4096;
            for (int k = tid; k < 2048; k += NTHR) { sc[k] = silu_f(p.c[k]); sc[2048 + k] = silu_f(p.cctx[k]); }
            __syncthreads();
            const int c4 = tid & 31, kg = tid >> 5;
            f32x4 a0 = {0.f, 0.f, 0.f, 0.f}, a1 = {0.f, 0.f, 0.f, 0.f};
            const float* wp = p.w_ada + (size_t)layer * 2048 * 6144 + n0 + 4 * c4;
#pragma unroll 8
            for (int k = kg; k < 2048; k += 16) { const f32x4 w = *(const f32x4*)(wp + (size_t)k * 6144); a0 += sc[k] * w; a1 += sc[2048 + k] * w; }
#pragma unroll
            for (int j = 0; j < 4; ++j) { red[(kg * 2 + 0) * 128 + 4 * c4 + j] = a0[j]; red[(kg * 2 + 1) * 128 + 4 * c4 + j] = a1[j]; }
            __syncthreads();
            if (tid < 256) { const int which = tid >> 7, col = tid & 127; float s = 0.f;
#pragma unroll
                for (int g = 0; g < 16; ++g) s += red[(g * 2 + which) * 128 + col];
                ((float*)(ws + WS_MOD))[(layer * 2 + which) * 6144 + n0 + col] = s + p.b_ada[layer * 6144 + n0 + col]; }
            __syncthreads();
        } else if (it < 128) {
            const int ldg = (it - 96) * 8 + wid, pidx = ldg * 64 + lane;
            const float ar = p.a_re[pidx], ai = p.a_im[pidx], dt = __expf(p.log_dt[ldg]);
            const float zr = dt * ar, zi = dt * ai;
            float sn, cs; sincosf(zi, &sn, &cs);
            const float mag = expf(zr);
            const float abx = mag * cs, aby = mag * sn;
            const float sh = sinf(0.5f * zi);
            const float ex = expm1f(zr) * cs - 2.0f * sh * sh, ey = aby;
            const float den = 1.0f / ((ar * ar + ai * ai) * dt);
            const float cx = (ex * ar + ey * ai) * den, cy = (ey * ar - ex * ai) * den;
            ((f32x2*)(ws + WS_ABAR))[pidx] = (f32x2){abx, aby};
            float px = abx, py = aby;
#pragma unroll
            for (int s = 0; s < 6; ++s) { const float nx = px * px - py * py, ny = 2.0f * px * py; px = nx; py = ny; }
            ((f32x2*)(ws + WS_APOW))[pidx] = (f32x2){px, py};
            f16* bm = (f16*)(ws + WS_BMAT) + (size_t)ldg * 2048 + (2 * lane) * 16;
            const float* br = p.b_re + (size_t)pidx * 16; const float* bi = p.b_im + (size_t)pidx * 16;
#pragma unroll
            for (int ch = 0; ch < 16; ++ch) { const float r = br[ch], i = bi[ch]; bm[ch] = (f16)(cx * r - cy * i); bm[16 + ch] = (f16)(cx * i + cy * r); }
            f16* cm = (f16*)(ws + WS_CMAT) + (size_t)ldg * 2048 + 2 * lane;
#pragma unroll
            for (int h = 0; h < 16; ++h) { const float r = p.c_re[((size_t)ldg * 16 + h) * 64 + lane], i = p.c_im[((size_t)ldg * 16 + h) * 64 + lane];
                h2 v; v[0] = (f16)r; v[1] = (f16)(-i); *(h2*)(cm + h * 128) = v; }
        } else {
            const int t = it - 128, layer = t / 4352, r = t % 4352;
            LAS float* tile = (LAS float*)lds;
            if (r < 3072) transpose_tile(p.w_in + (size_t)layer * 2048 * 6144, 6144, (f16*)(ws + WS_WIN) + (size_t)layer * 6144 * 2048, 2048, r / 96, r % 96, tile);
            else if (r < 4096) { const int q = r - 3072; transpose_tile(p.w_out + (size_t)layer * 2048 * 2048, 2048, (f16*)(ws + WS_WOUT) + (size_t)layer * 2048 * 2048, 2048, q / 32, q % 32, tile); }
            else { const int q = r - 4096; transpose_tile(p.w_glu + (size_t)layer * 1024 * 1024, 1024, (f16*)(ws + WS_WGLU) + (size_t)layer * 1024 * 1024, 1024, q / 16, q % 16, tile); }
        }
    }
}

__device__ void phase_modulate0(const Params& p) {
    int tid = threadIdx.x; asm volatile("" : "+v"(tid));
    const int wid = __builtin_amdgcn_readfirstlane(tid >> 6), lane = tid & 63;
    const float* mod = (const float*)(p.ws + WS_MOD);
    f16* A = (f16*)(p.ws + WS_AO);
    for (int T = blockIdx.x * 8 + wid; T < NTOK; T += gridDim.x * 8) {
        const float* src = T < NCTX ? p.ctx + (size_t)T * D : p.x + (size_t)(T - NCTX) * D;
        const float* md = mod + (T < NCTX ? 6144 : 0);
        f32x4 v[8];
#pragma unroll
        for (int i = 0; i < 4; ++i) { v[2 * i] = *(const f32x4*)(src + 8 * lane + 512 * i); v[2 * i + 1] = *(const f32x4*)(src + 8 * lane + 512 * i + 4); }
        float s = 0.f;
#pragma unroll
        for (int i = 0; i < 8; ++i) s += (v[i][0] + v[i][1]) + (v[i][2] + v[i][3]);
        const float mu = wave_sum(s) * (1.0f / D);
        float q = 0.f;
#pragma unroll
        for (int i = 0; i < 8; ++i) { const f32x4 d = v[i] - mu; q += (d[0] * d[0] + d[1] * d[1]) + (d[2] * d[2] + d[3] * d[3]); }
        const float rstd = rsqrtf(wave_sum(q) * (1.0f / D) + LN_EPS);
#pragma unroll
        for (int i = 0; i < 4; ++i) { const int col = 8 * lane + 512 * i;
            const f32x4 s0 = *(const f32x4*)(md + 2048 + col), s1 = *(const f32x4*)(md + 2048 + col + 4), h0 = *(const f32x4*)(md + col), h1 = *(const f32x4*)(md + col + 4);
            const f32x4 o0 = (v[2 * i] - mu) * rstd * (1.0f + s0) + h0, o1 = (v[2 * i + 1] - mu) * rstd * (1.0f + s1) + h1;
            *(h8*)(A + (size_t)T * D + col) = pack8(o0, o1); }
    }
}
__device__ void phase_postnorm(const Params& p, int layer) {
    int tid = threadIdx.x; asm volatile("" : "+v"(tid));
    const int wid = __builtin_amdgcn_readfirstlane(tid >> 6), lane = tid & 63;
    const bool has_next = layer == 0;
    const float* mod = (const float*)(p.ws + WS_MOD) + (size_t)(layer + 1) * 2 * 6144;
    const float* lg = p.ln_g + layer * D; const float* lb = p.ln_b + layer * D;
    f16* A = (f16*)(p.ws + WS_AO);
    const int T0 = has_next ? 0 : NCTX;
    for (int T = T0 + blockIdx.x * 8 + wid; T < NTOK; T += gridDim.x * 8) {
        float* row = T < NCTX ? (float*)(p.ws + WS_CTXV) + (size_t)T * D : p.out + (size_t)(T - NCTX) * D;
        float* dst = T < NCTX ? (float*)(p.ws + WS_CTXN) + (size_t)T * D : row;
        f32x4 v[8];
#pragma unroll
        for (int i = 0; i < 4; ++i) { v[2 * i] = *(const f32x4*)(row + 8 * lane + 512 * i); v[2 * i + 1] = *(const f32x4*)(row + 8 * lane + 512 * i + 4); }
        float s = 0.f;
#pragma unroll
        for (int i = 0; i < 8; ++i) s += (v[i][0] + v[i][1]) + (v[i][2] + v[i][3]);
        const float mu = wave_sum(s) * (1.0f / D);
        float q = 0.f;
#pragma unroll
        for (int i = 0; i < 8; ++i) { const f32x4 d = v[i] - mu; q += (d[0] * d[0] + d[1] * d[1]) + (d[2] * d[2] + d[3] * d[3]); }
        const float rstd = rsqrtf(wave_sum(q) * (1.0f / D) + LN_EPS);
        float s2 = 0.f;
#pragma unroll
        for (int i = 0; i < 4; ++i) { const int col = 8 * lane + 512 * i;
            const f32x4 g0 = *(const f32x4*)(lg + col), g1 = *(const f32x4*)(lg + col + 4), b0 = *(const f32x4*)(lb + col), b1 = *(const f32x4*)(lb + col + 4);
            v[2 * i] = (v[2 * i] - mu) * rstd * g0 + b0; v[2 * i + 1] = (v[2 * i + 1] - mu) * rstd * g1 + b1;
            *(f32x4*)(dst + col) = v[2 * i]; *(f32x4*)(dst + col + 4) = v[2 * i + 1];
            s2 += (v[2 * i][0] + v[2 * i][1]) + (v[2 * i][2] + v[2 * i][3]) + (v[2 * i + 1][0] + v[2 * i + 1][1]) + (v[2 * i + 1][2] + v[2 * i + 1][3]); }
        if (has_next) {
            const float* md = mod + (T < NCTX ? 6144 : 0);
            const float mu2 = wave_sum(s2) * (1.0f / D);
            float q2 = 0.f;
#pragma unroll
            for (int i = 0; i < 8; ++i) { const f32x4 d = v[i] - mu2; q2 += (d[0] * d[0] + d[1] * d[1]) + (d[2] * d[2] + d[3] * d[3]); }
            const float rstd2 = rsqrtf(wave_sum(q2) * (1.0f / D) + LN_EPS);
#pragma unroll
            for (int i = 0; i < 4; ++i) { const int col = 8 * lane + 512 * i;
                const f32x4 s0 = *(const f32x4*)(md + 2048 + col), s1 = *(const f32x4*)(md + 2048 + col + 4), h0 = *(const f32x4*)(md + col), h1 = *(const f32x4*)(md + col + 4);
                const f32x4 o0 = (v[2 * i] - mu2) * rstd2 * (1.0f + s0) + h0, o1 = (v[2 * i + 1] - mu2) * rstd2 * (1.0f + s1) + h1;
                *(h8*)(A + (size_t)T * D + col) = pack8(o0, o1); }
        }
    }
}

__device__ void phase_conv(const Params& p, int layer) {
    const f16* P = (const f16*)(p.ws + WS_P); f16* O = (f16*)(p.ws + WS_AO);
    const float* cw = p.conv_w + layer * 3 * 1024; const float* cb = p.conv_b + layer * 1024;
    int tid = threadIdx.x; asm volatile("" : "+v"(tid));
    for (int idx = blockIdx.x * NTHR + tid; idx < NTOK * 128; idx += gridDim.x * NTHR) {
        const int T = idx >> 7, j = (idx & 127) * 8;
        const bool hl = T < NCTX ? (T > 0) : ((T & 63) != 0), hr = T < NCTX ? (T < NCTX - 1) : ((T & 63) != 63);
        const f16* pr = P + (size_t)T * DIN;
        const h8 v1 = *(const h8*)(pr + 2048 + j), c1 = *(const h8*)(pr + 4096 + j), bg = *(const h8*)(pr + 3072 + j), zc = *(const h8*)(pr + 5120 + j);
        h8 v0 = v1, c0 = c1, v2 = v1, c2 = c1;
        if (hl) { v0 = *(const h8*)(pr - DIN + 2048 + j); c0 = *(const h8*)(pr - DIN + 4096 + j); }
        if (hr) { v2 = *(const h8*)(pr + DIN + 2048 + j); c2 = *(const h8*)(pr + DIN + 4096 + j); }
        const f32x4 w0a = *(const f32x4*)(cw + j), w0b = *(const f32x4*)(cw + j + 4), w1a = *(const f32x4*)(cw + 1024 + j), w1b = *(const f32x4*)(cw + 1024 + j + 4),
            w2a = *(const f32x4*)(cw + 2048 + j), w2b = *(const f32x4*)(cw + 2048 + j + 4), ba = *(const f32x4*)(cb + j), bb = *(const f32x4*)(cb + j + 4);
        h8 o;
#pragma unroll
        for (int e = 0; e < 8; ++e) {
            const float w0 = e < 4 ? w0a[e & 3] : w0b[e & 3], w1 = e < 4 ? w1a[e & 3] : w1b[e & 3], w2 = e < 4 ? w2a[e & 3] : w2b[e & 3], b = e < 4 ? ba[e & 3] : bb[e & 3];
            const float sl = hl ? (float)c0[e] * (float)v0[e] : 0.f, sm = (float)c1[e] * (float)v1[e], sr = hr ? (float)c2[e] * (float)v2[e] : 0.f;
            const float conv = w0 * sl + w1 * sm + w2 * sr + b;
            o[e] = (f16)((float)bg[e] * conv * silu_f((float)zc[e]));
        }
        *(h8*)(O + (size_t)T * D + 1024 + j) = o;
    }
}

template <bool PASS2>
__device__ void phase_s5(const Params& p, int layer, LAS unsigned char* lds) {
    int tid = threadIdx.x; asm volatile("" : "+v"(tid));
    const int wid = __builtin_amdgcn_readfirstlane(tid >> 6), lane = tid & 63;
    const int gl = wid >> 1, dir = wid & 1, fr = lane & 15, fq = lane >> 4;
    unsigned char* ws = p.ws;
    const f16* P = (const f16*)(ws + WS_P);
    LAS float* bu = (LAS float*)(lds + wid * 12800);
    LAS unsigned* Hb = (LAS unsigned*)(lds + wid * 12800 + 8448);
    LAS float* Yb = (LAS float*)(lds + 102400);
    for (int item = blockIdx.x; item < NCH * 16; item += gridDim.x) {
        const int c = item >> 4, gq = item & 15, g = gq * 4 + gl;
        const int ldg = (layer * 2 + dir) * 64 + g;
        const int q = dir == 0 ? c : (c < 4 ? 3 - c : 135 - c);
        const f32x2 a = ((const f32x2*)(ws + WS_ABAR))[ldg * 64 + lane];
        const float dt = __expf(p.log_dt[ldg]);
        h4 bm[8];
#pragma unroll
        for (int t = 0; t < 8; ++t) bm[t] = *(const h4*)((const f16*)(ws + WS_BMAT) + (size_t)ldg * 2048 + (16 * t + fr) * 16 + 4 * fq);
        h8 cm[4];
        if (PASS2) {
#pragma unroll
            for (int kk = 0; kk < 4; ++kk) cm[kk] = *(const h8*)((const f16*)(ws + WS_CMAT) + (size_t)ldg * 2048 + fr * 128 + 32 * kk + 8 * fq);
        }
        float hr = 0.f, hi = 0.f;
        if (PASS2) { const f32x2 s = ((const f32x2*)(ws + WS_SCAR))[((size_t)(dir * NCH + q) * 64 + g) * 64 + lane]; hr = s[0]; hi = s[1]; }
#pragma unroll 1
        for (int ss = 0; ss < 4; ++ss) {
            const int sc = dir ? 3 - ss : ss, T0 = c * 64 + sc * 16;
            const h4 uf = *(const h4*)(P + (size_t)(T0 + fr) * DIN + g * 16 + 4 * fq);
#pragma unroll
            for (int t = 0; t < 8; ++t) {
                f32x4 r = __builtin_amdgcn_mfma_f32_16x16x16f16(bm[t], uf, (f32x4){0.f, 0.f, 0.f, 0.f}, 0, 0, 0);
                r *= dt;
                *(LAS f32x4*)(bu + fr * 132 + 16 * t + 4 * fq) = r;
            }
            __syncthreads();
#pragma unroll
            for (int i = 0; i < 16; ++i) {
                const int t = dir ? 15 - i : i;
                const f32x2 b = *(const LAS f32x2*)(bu + t * 132 + 2 * lane);
                const float nr = a[0] * hr - a[1] * hi + b[0], ni = a[0] * hi + a[1] * hr + b[1];
                hr = nr; hi = ni;
                if (PASS2) { h2 hv; hv[0] = (f16)hr; hv[1] = (f16)hi; Hb[t * 68 + lane] = __builtin_bit_cast(unsigned, hv); }
            }
            __syncthreads();
            if (PASS2) {
                f32x4 acc = {0.f, 0.f, 0.f, 0.f};
#pragma unroll
                for (int kk = 0; kk < 4; ++kk) { const h8 af = *(const LAS h8*)((LAS unsigned char*)Hb + fr * 272 + (32 * kk + 8 * fq) * 2);
                    acc = __builtin_amdgcn_mfma_f32_16x16x32_f16(af, cm[kk], acc, 0, 0, 0); }
#pragma unroll
                for (int r = 0; r < 4; ++r) Yb[(wid * 64 + sc * 16 + 4 * fq + r) * 16 + fr] = acc[r];
            }
        }
        if (!PASS2) {
            ((f32x2*)(ws + WS_EST))[((size_t)(dir * NCH + q) * 64 + g) * 64 + lane] = (f32x2){hr, hi};
        } else {
            __syncthreads();
            const int tok = tid >> 3, oct = tid & 7, g2 = oct >> 1, hf = oct & 1, T = c * 64 + tok, ch = gq * 64 + oct * 8;
            const h8 uv = *(const h8*)(P + (size_t)T * DIN + ch);
            const float* dsk = p.s5_d + layer * DS5 + ch;
            const f32x4 d0 = *(const f32x4*)dsk, d1 = *(const f32x4*)(dsk + 4);
            const LAS float* yf = Yb + ((g2 * 2 + 0) * 64 + tok) * 16 + 8 * hf; const LAS float* yb = Yb + ((g2 * 2 + 1) * 64 + tok) * 16 + 8 * hf;
            h8 o;
#pragma unroll
            for (int j = 0; j < 8; ++j) { const float y = (j < 4 ? d0[j & 3] : d1[j & 3]) * (float)uv[j] + yf[j] + yb[j]; o[j] = (f16)gelu_tanh_f(y); }
            *(h8*)((f16*)(ws + WS_G) + (size_t)T * DS5 + ch) = o;
            __syncthreads();
        }
    }
}
__device__ void phase_carry(const Params& p, int layer) {
    int tid = threadIdx.x; asm volatile("" : "+v"(tid));
    const int gt = blockIdx.x * NTHR + tid;
    if (gt >= 2 * 4096) return;
    const int dir = gt >> 12, gp = gt & 4095;
    const f32x2 a = ((const f32x2*)(p.ws + WS_APOW))[(layer * 2 + dir) * 4096 + gp];
    const f32x2* E = (const f32x2*)(p.ws + WS_EST) + (size_t)dir * NCH * 4096 + gp;
    f32x2* S = (f32x2*)(p.ws + WS_SCAR) + (size_t)dir * NCH * 4096 + gp;
    float sr = 0.f, si = 0.f;
#pragma unroll 1
    for (int q0 = 0; q0 < NCH; q0 += 33) {
        f32x2 e[33];
#pragma unroll
        for (int j = 0; j < 33; ++j) e[j] = E[(size_t)(q0 + j) * 4096];
#pragma unroll
        for (int j = 0; j < 33; ++j) { S[(size_t)(q0 + j) * 4096] = (f32x2){sr, si};
            const float nr = a[0] * sr - a[1] * si + e[j][0], ni = a[0] * si + a[1] * sr + e[j][1]; sr = nr; si = ni; }
    }
}

__global__ void __launch_bounds__(NTHR, 2) fwd_megakernel(Params p) {
    extern __shared__ __attribute__((aligned(16))) unsigned char lds_raw[];
    LAS unsigned char* lds = (LAS unsigned char*)lds_raw;
    cg::grid_group grid = cg::this_grid();
    unsigned char* ws = p.ws;
    const int lo = p.ph_lo, hi = p.ph_hi;
    int ph = 0;
#define PHASE_BEGIN if (ph >= lo && ph < hi) {
#define PHASE_END   if (ph + 1 < hi) grid.sync(); } ++ph;
    PHASE_BEGIN phase_prologue(p, lds); PHASE_END
    for (int layer = 0; layer < 2; ++layer) {
        const float* modl = (const float*)(ws + WS_MOD) + (size_t)layer * 2 * 6144;
        if (layer == 0) { PHASE_BEGIN phase_modulate0(p); PHASE_END }
        PHASE_BEGIN {
            pg8::Gemm g{(const f16*)(ws + WS_AO), (const f16*)(ws + WS_WIN) + (size_t)layer * 6144 * 2048, NTOK, DIN, D};
            pg8::StaticOrder S; S.init(NTOK, DIN, gridDim.x, blockIdx.x, 0);
            EpiP E{(f16*)(ws + WS_P)};
            pg8::gemm_phase<EpiP>(lds, g, S, E);
        } PHASE_END
        PHASE_BEGIN phase_s5<false>(p, layer, lds); phase_conv(p, layer); PHASE_END
        PHASE_BEGIN phase_carry(p, layer); PHASE_END
        PHASE_BEGIN phase_s5<true>(p, layer, lds); PHASE_END
        PHASE_BEGIN {
            pg8::Gemm g{(const f16*)(ws + WS_G), (const f16*)(ws + WS_WGLU) + (size_t)layer * 1024 * 1024, NTOK, DS5, DS5};
            pg8::StaticOrder S; S.init(NTOK, DS5, gridDim.x, blockIdx.x, 0);
            EpiGlu E{(const f16*)(ws + WS_G), (const f16*)(ws + WS_P), p.b_glu + layer * DS5, (f16*)(ws + WS_AO)};
            pg8::gemm_phase<EpiGlu>(lds, g, S, E);
        } PHASE_END
        PHASE_BEGIN {
            pg8::Gemm g{(const f16*)(ws + WS_AO), (const f16*)(ws + WS_WOUT) + (size_t)layer * 2048 * 2048, NTOK, D, D};
            pg8::StaticOrder S; S.init(NTOK, D, gridDim.x, blockIdx.x, 0);
            EpiOut E{layer == 0 ? p.x : p.out, layer == 0 ? p.ctx : (const float*)(ws + WS_CTXN), p.out, (float*)(ws + WS_CTXV), modl + 4096, modl + 6144 + 4096};
            pg8::gemm_phase<EpiOut>(lds, g, S, E);
        } PHASE_END
        PHASE_BEGIN phase_postnorm(p, layer); PHASE_END
    }
#undef PHASE_BEGIN
#undef PHASE_END
}
constexpr int N_PHASES = 16;

extern "C" void kernel_launch(void* const* d_in, const int* in_sizes, int n_in, void* d_out, int out_size, void* d_ws, size_t ws_size, hipStream_t stream) {
    static int grid_blocks = 0;
    if (!grid_blocks) {
        int dev = 0, cus = 0, per_cu = 0;
        hipGetDevice(&dev);
        hipDeviceGetAttribute(&cus, hipDeviceAttributeMultiprocessorCount, dev);
        hipFuncSetAttribute((const void*)fwd_megakernel, hipFuncAttributeMaxDynamicSharedMemorySize, LDS_BYTES);
        hipOccupancyMaxActiveBlocksPerMultiprocessor(&per_cu, (const void*)fwd_megakernel, NTHR, LDS_BYTES);
        if (per_cu < 1) { fprintf(stderr, "occupancy query says %d blocks/CU\n", per_cu); per_cu = 1; }
        grid_blocks = cus;
        if (ws_size < WS_END) fprintf(stderr, "workspace too small: %zu < %zu\n", ws_size, (size_t)WS_END);
    }
    Params p{};
    const float** pp = (const float**)&p;
    for (int i = 0; i < 22; ++i) pp[i] = (const float*)d_in[i];
    p.out = (float*)d_out; p.ws = (unsigned char*)d_ws;
#if N_LAUNCH_SPLIT
    for (int ph = 0; ph < N_PHASES; ++ph) { p.ph_lo = ph; p.ph_hi = ph + 1; hipLaunchKernelGGL(fwd_megakernel, dim3(grid_blocks), dim3(NTHR), LDS_BYTES, stream, p); }
#else
    p.ph_lo = 0; p.ph_hi = N_PHASES;
    void* args[] = {&p};
    hipError_t e = hipLaunchCooperativeKernel((const void*)fwd_megakernel, dim3(grid_blocks), dim3(NTHR), args, LDS_BYTES, stream);
    if (e != hipSuccess) fprintf(stderr, "cooperative launch failed: %s (grid %d)\n", hipGetErrorString(e), grid_blocks);
#endif
}
```

```cpp
#include <hip/hip_runtime.h>
#include <hip/hip_cooperative_groups.h>
#include <cstdio>
namespace cg = cooperative_groups;

#ifndef N_LAUNCH_SPLIT
#define N_LAUNCH_SPLIT 0
#endif

#define LAS __attribute__((address_space(3)))
typedef _Float16 f16;
typedef _Float16 h8 __attribute__((ext_vector_type(8)));
typedef _Float16 h4 __attribute__((ext_vector_type(4)));
typedef _Float16 h2 __attribute__((ext_vector_type(2)));
typedef float f32x4 __attribute__((ext_vector_type(4)));
typedef float f32x2 __attribute__((ext_vector_type(2)));

constexpr int D = 2048, NCTX = 256, NLAT = 8192, NTOK = 8448, DIN = 6144, DS5 = 1024;
constexpr int NCH = 132;
constexpr int NTHR = 512;
constexpr float ALPHA = 1.4142135623730951f;
constexpr float LN_EPS = 1e-6f;

constexpr size_t WS_CTL = 0;
constexpr size_t WS_MOD = 16384;
constexpr size_t WS_ABAR = WS_MOD + 98304;
constexpr size_t WS_APOW = WS_ABAR + 131072;
constexpr size_t WS_BMAT = WS_APOW + 131072;
constexpr size_t WS_CMAT = WS_BMAT + 1048576;
constexpr size_t WS_EST = WS_CMAT + 1048576;
constexpr size_t WS_SCAR = WS_EST + 8650752;
constexpr size_t WS_CTXV = WS_SCAR + 8650752;
constexpr size_t WS_CTXN = WS_CTXV + 2097152;
constexpr size_t WS_WIN = WS_CTXN + 2097152;
constexpr size_t WS_WOUT = WS_WIN + 50331648;
constexpr size_t WS_WGLU = WS_WOUT + 16777216;
constexpr size_t WS_AO = WS_WGLU + 4194304;
constexpr size_t WS_P = WS_AO + 34603008;
constexpr size_t WS_G = WS_P + 103809024;
constexpr size_t WS_END = WS_G + 17301504;

constexpr int LDS_BYTES = 139264;

struct Params {
    const float *x, *c, *ctx, *cctx, *w_ada, *b_ada, *w_in, *a_re, *a_im, *log_dt, *b_re, *b_im, *c_re, *c_im, *s5_d, *w_glu, *b_glu,
        *conv_w, *conv_b, *w_out, *ln_g, *ln_b;
    float* out; unsigned char* ws; int ph_lo, ph_hi;
};

__device__ __forceinline__ float silu_f(float v) { return v / (1.0f + __expf(-v)); }
__device__ __forceinline__ float sigmoid_f(float v) { return 1.0f / (1.0f + __expf(-v)); }
__device__ __forceinline__ float gelu_tanh_f(float v) {
    const float z = 0.7978845608028654f * (v + 0.044715f * v * v * v);
    const float th = 1.0f - 2.0f / (__expf(2.0f * z) + 1.0f);
    return 0.5f * v * (1.0f + th);
}
__device__ __forceinline__ float wave_sum(float v) {
#pragma unroll
    for (int o = 32; o >= 1; o >>= 1) v += __shfl_xor(v, o);
    return v;
}

#define XB_TMO      128
#define XB_XCNT(j)  (256  + 64 * (j))
#define XB_XSUB(j)  (1280 + 64 * (j))
#define XB_XGEN(j)  (2304 + 64 * (j))
#define XB_TOP      3328
#define XB_TOPGEN   3392
#define XCD_BAR_WORDS 3456
#define XB_SPIN_CAP (1u << 18)
__device__ __forceinline__ unsigned xb_ld(unsigned* p)              { return __hip_atomic_load(p, __ATOMIC_RELAXED, __HIP_MEMORY_SCOPE_AGENT); }
__device__ __forceinline__ unsigned xb_add(unsigned* p, unsigned v) { return __hip_atomic_fetch_add(p, v, __ATOMIC_RELAXED, __HIP_MEMORY_SCOPE_AGENT); }
__device__ __forceinline__ unsigned xb_xcc_id() { return (unsigned)__builtin_amdgcn_s_getreg((3 << 11) | 20) & 0xFu; }
#define XB_SPIN(cond, bar) do { unsigned _sp = 0; while (cond) { __builtin_amdgcn_s_sleep(1); \
    if ((++_sp & 255u) == 0u) { if (xb_ld(&(bar)[XB_TMO])) break; if (_sp > XB_SPIN_CAP) { atomicAdd(&(bar)[XB_TMO], 1u); break; } } } } while (0)
struct XcdBarrier { unsigned* bar; unsigned x; volatile LAS unsigned* st; };
__device__ __forceinline__ XcdBarrier xcd_barrier_post(unsigned* bar, volatile LAS unsigned* st) {
    XcdBarrier b; b.bar = bar; b.x = xb_xcc_id(); b.st = st;
    if (threadIdx.x == 0) (void)xb_add(&bar[XB_XCNT(b.x)], 1u);
    return b;
}
__device__ __forceinline__ void xcd_barrier_complete(unsigned* bar, unsigned x, unsigned& nloc, unsigned& nx) {
    const unsigned G = gridDim.x * gridDim.y * gridDim.z;
    unsigned sum, cnt, mine, sp = 0u;
    for (;;) {
        sum = 0u; cnt = 0u; mine = 0u;
#pragma unroll
        for (unsigned j = 0; j < 16; ++j) { const unsigned c = xb_ld(&bar[XB_XCNT(j)]); sum += c; cnt += (c > 0u) ? 1u : 0u; mine = (j == x) ? c : mine; }
        if (sum == G) break;
        __builtin_amdgcn_s_sleep(1);
        if ((++sp & 255u) == 0u) { if (xb_ld(&bar[XB_TMO])) break; if (sp > XB_SPIN_CAP) { atomicAdd(&bar[XB_TMO], 1u); break; } }
    }
    nloc = mine > 0u ? mine : 1u; nx = cnt > 0u ? cnt : 1u;
}
__device__ __forceinline__ void xcd_barrier(const XcdBarrier& b) {
    asm volatile("s_waitcnt vmcnt(0)" ::: "memory");
    __syncthreads();
    if (threadIdx.x == 0) {
        unsigned* bar = b.bar;
        __builtin_amdgcn_s_waitcnt(0);
        unsigned nloc = b.st[0], nx = b.st[1];
        if (nloc == 0u) { xcd_barrier_complete(bar, b.x, nloc, nx); b.st[0] = nloc; b.st[1] = nx; }
        const unsigned old = xb_add(&bar[XB_XSUB(b.x)], 1u);
        const unsigned gen = old / nloc;
        if (old + 1u == (gen + 1u) * nloc) {
            __builtin_amdgcn_fence(__ATOMIC_RELEASE, "agent");
            asm volatile("s_waitcnt vmcnt(0)" ::: "memory");
            const unsigned og = xb_add(&bar[XB_TOP], 1u);
            const unsigned tg = og / nx;
            if (og + 1u == (tg + 1u) * nx) xb_add(&bar[XB_TOPGEN], 1u);
            else XB_SPIN(xb_ld(&bar[XB_TOPGEN]) == tg, bar);
            __builtin_amdgcn_fence(__ATOMIC_ACQUIRE, "agent");
            xb_add(&bar[XB_XGEN(b.x)], 1u);
            asm volatile("s_waitcnt vmcnt(0)" ::: "memory");
        } else {
            XB_SPIN(xb_ld(&bar[XB_XGEN(b.x)]) == gen, bar);
            __builtin_amdgcn_fence(__ATOMIC_ACQUIRE, "agent");
            asm volatile("s_waitcnt vmcnt(0)" ::: "memory");
        }
    }
    __syncthreads();
}

namespace pg8 {
constexpr int BM = 256, BK = 64, HALF = 128, HTB = HALF * BK * 2, STAGE_BYTES = 8 * HTB, NXCD = 8, WGM = 8;
__device__ __forceinline__ int lds_byte(int r, int c) { const int st = (r >> 4) * 2 + (c >> 5), rr = r & 15, cc = c & 31, ob = rr * 64 + cc * 2; return st * 1024 + (ob ^ (((ob >> 9) & 1) << 5)); }
__device__ __forceinline__ void stage_rc(int b, int& R, int& C) { const int st = b / 1024, sb = b % 1024, swz = sb ^ (((sb >> 9) & 1) << 5); R = (st >> 1) * 16 + swz / 64; C = (st & 1) * 32 + (swz % 64) / 2; }
__device__ __forceinline__ int perm32(int rho) { const int n = rho >> 4, i = rho & 15; return 8 * (i >> 2) + 4 * n + (i & 3); }
struct Unit { int pm, pn; };
struct Gemm { const f16* A; const f16* Bt; int M, N, K; };
struct StaticOrder {
    int nM, nN, nwg, G, c, pm0, nextra;
    __device__ void init(int M, int N, int G_, int c_, int pm0_, int nextra_) { nM = M / BM; nN = N / BM; nwg = nM * nN; G = G_; c = c_; pm0 = pm0_; nextra = nextra_; }
    __device__ bool next(int i, Unit& u) const {
        const long L = (long)i * G + c; if (L >= nwg + nextra) return false;
        if (L >= nwg) { u.pm = 0; u.pn = (int)L - nwg; return true; }
        int wgid = (int)L; { const int q = nwg / NXCD, r = nwg % NXCD, xcd = wgid % NXCD, off = wgid / NXCD; wgid = (xcd < r ? xcd * (q + 1) : r * (q + 1) + (xcd - r) * q) + off; }
        const int nig = WGM * nN, gid = wgid / nig, fm = gid * WGM, gsz = (nM - fm) < WGM ? (nM - fm) : WGM;
        u.pm = pm0 + fm + ((wgid % nig) % gsz); u.pn = (wgid % nig) / gsz; return true;
    }
};

template <class Epi>
__device__ __forceinline__ void gemm_phase(LAS unsigned char* lds, const Gemm g, const StaticOrder& S, const Epi& E) {
    int tid = threadIdx.x; asm volatile("" : "+v"(tid));
    const int wid = __builtin_amdgcn_readfirstlane(tid >> 6), lane = tid & 63, wr = wid >> 2, wc = wid & 3, fr = lane & 15, fq = lane >> 4;
    const int K = g.K, nt = K / BK;
    unsigned voffA[2], voffB[2];
#pragma unroll
    for (int i = 0; i < 2; ++i) { int R, C; stage_rc(tid * 16 + i * 8192, R, C); const int Rb = Epi::PERM ? ((R & ~31) + perm32(R & 31)) : R;
        voffA[i] = (unsigned)(R * K + C) * 2u; voffB[i] = (unsigned)(Rb * K + C) * 2u; }
    const size_t kstep = (size_t)(BK * 2);
    const size_t hstep = (size_t)HALF * K * 2;
    const size_t tstep = 2 * hstep;
    const unsigned ldsw = (unsigned)wid * 1024u;
    const int aoff = lds_byte(wr * 64 + fr, fq * 8), boff = lds_byte(wc * 32 + fr, fq * 8);
#define PG8_SA(b, h) (((b) * 2 + (h)) * HTB)
#define PG8_SB(b, h) ((4 + (b) * 2 + (h)) * HTB)
#define PG8_STAGE(bufoff, gbase, voff) do { _Pragma("unroll") for (int _i = 0; _i < 2; ++_i) \
        __builtin_amdgcn_global_load_lds((const unsigned*)((const char*)(gbase) + (voff)[_i]), (LAS unsigned*)(lds + (bufoff) + ldsw + _i * 8192), 16, 0, 0); } while (0)
#define PG8_LDA(dst, b, h) do { _Pragma("unroll") for (int m = 0; m < 4; ++m) _Pragma("unroll") for (int k = 0; k < 2; ++k) dst[m][k] = *(const LAS h8*)(lds + PG8_SA(b, h) + aoff + m * 2048 + k * 1024); } while (0)
#define PG8_LDB(dst, b, h) do { _Pragma("unroll") for (int n = 0; n < 2; ++n) _Pragma("unroll") for (int k = 0; k < 2; ++k) dst[n][k] = *(const LAS h8*)(lds + PG8_SB(b, h) + boff + n * 2048 + k * 1024); } while (0)
#define PG8_MMA(ai, bj, At, Bt) do { __builtin_amdgcn_s_setprio(1); _Pragma("unroll") for (int m = 0; m < 4; ++m) _Pragma("unroll") for (int n = 0; n < 2; ++n) _Pragma("unroll") for (int k = 0; k < 2; ++k) \
        acc[ai][bj][m][n] = __builtin_amdgcn_mfma_f32_16x16x32_f16(Bt[n][k], At[m][k], acc[ai][bj][m][n], 0, 0, 0); __builtin_amdgcn_s_setprio(0); } while (0)
#define PG8_WAIT_V(n) asm volatile("s_waitcnt vmcnt(" #n ")" ::: "memory")
#define PG8_WAIT_L(n) asm volatile("s_waitcnt lgkmcnt(" #n ")" ::: "memory")
#define PG8_BAR __builtin_amdgcn_s_barrier()
#define PG8_SCHED __builtin_amdgcn_sched_barrier(0)
    Unit cur, nxt; int ui = 0;
    if (!S.next(0, cur)) return;
    f32x4 acc[2][2][4][2];
#pragma unroll
    for (int a = 0; a < 2; ++a)
#pragma unroll
        for (int b = 0; b < 2; ++b)
#pragma unroll
            for (int m = 0; m < 4; ++m)
#pragma unroll
                for (int n = 0; n < 2; ++n) acc[a][b][m][n] = (f32x4){0.f, 0.f, 0.f, 0.f};
    h8 At[4][2], B0[2][2], B1[2][2];
    const char* cA = (const char*)g.A + (size_t)cur.pm * tstep; const char* cB = (const char*)g.Bt + (size_t)cur.pn * tstep;
    PG8_STAGE(PG8_SB(0, 0), cB, voffB); PG8_STAGE(PG8_SA(0, 0), cA, voffA); PG8_STAGE(PG8_SB(0, 1), cB + hstep, voffB); PG8_STAGE(PG8_SA(0, 1), cA + hstep, voffA);
    if (wr == 1) PG8_BAR;
    PG8_WAIT_V(4); PG8_BAR;
    PG8_STAGE(PG8_SB(1, 0), cB + kstep, voffB); PG8_STAGE(PG8_SA(1, 0), cA + kstep, voffA); PG8_STAGE(PG8_SB(1, 1), cB + hstep + kstep, voffB);
    PG8_WAIT_V(6); PG8_BAR;
    for (;;) {
        const bool has_next = S.next(ui + 1, nxt);
        const char* nA = has_next ? (const char*)g.A + (size_t)nxt.pm * tstep : cA; const char* nB = has_next ? (const char*)g.Bt + (size_t)nxt.pn * tstep : cB;
        for (int t = 0; t < nt; t += 2) {
            const bool last = (t == nt - 2);
            const char* a1 = cA + (size_t)(t + 1) * kstep;
            const char* a2 = last ? nA : cA + (size_t)(t + 2) * kstep; const char* b2 = last ? nB : cB + (size_t)(t + 2) * kstep;
            const char* a3 = a2 + kstep; const char* b3 = b2 + kstep;
            PG8_LDB(B0, 0, 0); PG8_SCHED; PG8_LDA(At, 0, 0); PG8_STAGE(PG8_SA(1, 1), a1 + hstep, voffA);
            PG8_WAIT_L(8); PG8_BAR; PG8_WAIT_L(0); PG8_MMA(0, 0, At, B0); PG8_BAR; PG8_SCHED;
            PG8_LDB(B1, 0, 1); PG8_STAGE(PG8_SB(0, 0), b2, voffB);
            PG8_BAR; PG8_WAIT_L(0); PG8_MMA(0, 1, At, B1); PG8_BAR;
            PG8_LDA(At, 0, 1); PG8_STAGE(PG8_SA(0, 0), a2, voffA);
            PG8_BAR; PG8_WAIT_L(0); PG8_MMA(1, 0, At, B0); PG8_BAR; PG8_SCHED;
            PG8_STAGE(PG8_SB(0, 1), b2 + hstep, voffB);
            PG8_WAIT_V(6); PG8_BAR; PG8_MMA(1, 1, At, B1); PG8_BAR;
            PG8_LDB(B0, 1, 0); PG8_SCHED; PG8_LDA(At, 1, 0); PG8_STAGE(PG8_SA(0, 1), a2 + hstep, voffA);
            PG8_WAIT_L(8); PG8_BAR; PG8_WAIT_L(0); PG8_MMA(0, 0, At, B0); PG8_BAR; PG8_SCHED;
            PG8_LDB(B1, 1, 1); PG8_STAGE(PG8_SB(1, 0), b3, voffB);
            PG8_BAR; PG8_WAIT_L(0); PG8_MMA(0, 1, At, B1); PG8_BAR;
            PG8_LDA(At, 1, 1); PG8_STAGE(PG8_SA(1, 0), a3, voffA);
            PG8_BAR; PG8_WAIT_L(0); PG8_MMA(1, 0, At, B0); PG8_BAR; PG8_SCHED;
            PG8_STAGE(PG8_SB(1, 1), b3 + hstep, voffB);
            PG8_WAIT_V(6); PG8_BAR; PG8_MMA(1, 1, At, B1); PG8_BAR;
        }
        E(acc, cur, wr, wc, fr, fq);
        if (!has_next) break;
#pragma unroll
        for (int a = 0; a < 2; ++a)
#pragma unroll
            for (int b = 0; b < 2; ++b)
#pragma unroll
                for (int m = 0; m < 4; ++m)
#pragma unroll
                    for (int n = 0; n < 2; ++n) acc[a][b][m][n] = (f32x4){0.f, 0.f, 0.f, 0.f};
        cur = nxt; cA = nA; cB = nB; ++ui;
    }
    PG8_WAIT_V(0);
    if (wr == 0) PG8_BAR;
    PG8_BAR;
#undef PG8_SA
#undef PG8_SB
#undef PG8_STAGE
#undef PG8_LDA
#undef PG8_LDB
#undef PG8_MMA
#undef PG8_WAIT_V
#undef PG8_WAIT_L
#undef PG8_BAR
#undef PG8_SCHED
}
}

__device__ __forceinline__ h8 pack8(const f32x4 a, const f32x4 b) {
    h8 r; r[0] = (f16)a[0]; r[1] = (f16)a[1]; r[2] = (f16)a[2]; r[3] = (f16)a[3]; r[4] = (f16)b[0]; r[5] = (f16)b[1]; r[6] = (f16)b[2]; r[7] = (f16)b[3]; return r;
}

struct EpiP {
    static constexpr bool PERM = true;
    f16* P;
    __device__ __forceinline__ void operator()(const f32x4 (&acc)[2][2][4][2], const pg8::Unit& u, int wr, int wc, int fr, int fq) const {
        const int row0 = u.pm * 256 + wr * 64 + fr, col0 = u.pn * 256 + wc * 32 + 8 * fq;
#pragma unroll
        for (int ai = 0; ai < 2; ++ai)
#pragma unroll
            for (int m = 0; m < 4; ++m) { f16* rowp = P + (size_t)(row0 + ai * 128 + m * 16) * DIN + col0;
#pragma unroll
                for (int bj = 0; bj < 2; ++bj) *(h8*)(rowp + bj * 128) = pack8(acc[ai][bj][m][0], acc[ai][bj][m][1]); }
    }
};
struct EpiGlu {
    static constexpr bool PERM = true;
    const f16* G; const f16* P; const float* bglu; f16* O;
    __device__ __forceinline__ void operator()(const f32x4 (&acc)[2][2][4][2], const pg8::Unit& u, int wr, int wc, int fr, int fq) const {
        const int row0 = u.pm * 256 + wr * 64 + fr, col0 = u.pn * 256 + wc * 32 + 8 * fq;
        f32x4 bv[2][2];
#pragma unroll
        for (int bj = 0; bj < 2; ++bj) { bv[bj][0] = *(const f32x4*)(bglu + col0 + bj * 128); bv[bj][1] = *(const f32x4*)(bglu + col0 + bj * 128 + 4); }
#pragma unroll
        for (int ai = 0; ai < 2; ++ai)
#pragma unroll
            for (int m = 0; m < 4; ++m) { const size_t row = (size_t)(row0 + ai * 128 + m * 16);
#pragma unroll
                for (int bj = 0; bj < 2; ++bj) { const int col = col0 + bj * 128;
                    const h8 gv = *(const h8*)(G + row * DS5 + col); const h8 zv = *(const h8*)(P + row * DIN + DS5 + col);
                    h8 o;
#pragma unroll
                    for (int j = 0; j < 8; ++j) { const float t = acc[ai][bj][m][j >> 2][j & 3] + bv[bj][j >> 2][j & 3]; const float z = (float)zv[j];
                        o[j] = (f16)((float)gv[j] * sigmoid_f(t) * silu_f(z)); }
                    *(h8*)(O + row * D + col) = o; } }
    }
};
struct EpiOut {
    static constexpr bool PERM = false;
    const float* xres_lat; const float* xres_ctx; float* v_lat; float* v_ctx; const float* gate_lat; const float* gate_ctx;
    __device__ __forceinline__ void operator()(const f32x4 (&acc)[2][2][4][2], const pg8::Unit& u, int wr, int wc, int fr, int fq) const {
        const bool isctx = (u.pm == 0);
        const float* xr = isctx ? xres_ctx : xres_lat - (size_t)NCTX * D; float* vo = isctx ? v_ctx : v_lat - (size_t)NCTX * D; const float* gt = isctx ? gate_ctx : gate_lat;
        const int row0 = u.pm * 256 + wr * 64 + fr, col0 = u.pn * 256 + wc * 32 + 4 * fq;
        f32x4 gv[2][2];
#pragma unroll
        for (int bj = 0; bj < 2; ++bj)
#pragma unroll
            for (int n = 0; n < 2; ++n) gv[bj][n] = *(const f32x4*)(gt + col0 + bj * 128 + n * 16);
#pragma unroll
        for (int ai = 0; ai < 2; ++ai)
#pragma unroll
            for (int m = 0; m < 4; ++m) { const size_t off = (size_t)(row0 + ai * 128 + m * 16) * D + col0;
#pragma unroll
                for (int bj = 0; bj < 2; ++bj)
#pragma unroll
                    for (int n = 0; n < 2; ++n) { const f32x4 xv = *(const f32x4*)(xr + off + bj * 128 + n * 16);
                        *(f32x4*)(vo + off + bj * 128 + n * 16) = ALPHA * xv + gv[bj][n] * acc[ai][bj][m][n]; } }
    }
};

__device__ void transpose_tile(const float* src, int N, f16* dst, int K, int tk, int tn, LAS f16* tile) {
    int tid = threadIdx.x; asm volatile("" : "+v"(tid));
    { const int r = tid >> 6, c4 = tid & 63; f32x4 v[8];
#pragma unroll
        for (int i = 0; i < 8; ++i) v[i] = *(const f32x4*)(src + (size_t)(tk * 64 + r + 8 * i) * N + tn * 256 + 4 * c4);
#pragma unroll
        for (int i = 0; i < 8; ++i) { h4 o; o[0] = (f16)v[i][0]; o[1] = (f16)v[i][1]; o[2] = (f16)v[i][2]; o[3] = (f16)v[i][3]; *(LAS h4*)(tile + (r + 8 * i) * 264 + 4 * c4) = o; } }
    __syncthreads();
    { const int n = (tid & 31) + 32 * (tid >> 6), kh = (tid >> 5) & 1;
#pragma unroll
        for (int i = 0; i < 4; ++i) { h8 o;
#pragma unroll
            for (int j = 0; j < 8; ++j) o[j] = tile[(32 * kh + 8 * i + j) * 264 + n];
            *(h8*)(dst + (size_t)(tn * 256 + n) * K + tk * 64 + 32 * kh + 8 * i) = o; } }
    __syncthreads();
}

__device__ void phase_prologue(const Params& p, LAS unsigned char* lds) {
    int tid = threadIdx.x; asm volatile("" : "+v"(tid));
    const int wid = __builtin_amdgcn_readfirstlane(tid >> 6), lane = tid & 63;
    unsigned char* ws = p.ws;
    const int total = 128 + 2176;
    const int nwork = (int)gridDim.x - 96;
    int it = blockIdx.x < 128 ? (int)blockIdx.x : 128 + (int)blockIdx.x - 96;
    for (; it < total; it = it < 96 ? total : (it < 128 ? 128 + (int)blockIdx.x - 96 : it + nwork)) {
        if (it < 96) {
            const int layer = it / 48, n0 = (it % 48) * 128;
            LAS float* sc = (LAS float*)lds;
            LAS float* red = sc + 4096;
            for (int k = tid; k < 2048; k += NTHR) { sc[k] = silu_f(p.c[k]); sc[2048 + k] = silu_f(p.cctx[k]); }
            __syncthreads();
            const int c4 = tid & 31, kg = tid >> 5;
            f32x4 a0 = {0.f, 0.f, 0.f, 0.f}, a1 = {0.f, 0.f, 0.f, 0.f};
            const float* wp = p.w_ada + (size_t)layer * 2048 * 6144 + n0 + 4 * c4;
#pragma unroll 8
            for (int k = kg; k < 2048; k += 16) { const f32x4 w = *(const f32x4*)(wp + (size_t)k * 6144); a0 += sc[k] * w; a1 += sc[2048 + k] * w; }
#pragma unroll
            for (int j = 0; j < 4; ++j) { red[(kg * 2 + 0) * 128 + 4 * c4 + j] = a0[j]; red[(kg * 2 + 1) * 128 + 4 * c4 + j] = a1[j]; }
            __syncthreads();
            if (tid < 256) { const int which = tid >> 7, col = tid & 127; float s = 0.f;
#pragma unroll
                for (int g = 0; g < 16; ++g) s += red[(g * 2 + which) * 128 + col];
                ((float*)(ws + WS_MOD))[(layer * 2 + which) * 6144 + n0 + col] = s + p.b_ada[layer * 6144 + n0 + col]; }
            __syncthreads();
        } else if (it < 128) {
            const int ldg = (it - 96) * 8 + wid, pidx = ldg * 64 + lane;
            const float ar = p.a_re[pidx], ai = p.a_im[pidx], dt = __expf(p.log_dt[ldg]);
            const float zr = dt * ar, zi = dt * ai;
            float sn, cs; sincosf(zi, &sn, &cs);
            const float mag = expf(zr);
            const float abx = mag * cs, aby = mag * sn;
            const float sh = sinf(0.5f * zi);
            const float ex = expm1f(zr) * cs - 2.0f * sh * sh, ey = aby;
            const float den = 1.0f / ((ar * ar + ai * ai) * dt);
            const float cx = (ex * ar + ey * ai) * den, cy = (ey * ar - ex * ai) * den;
            ((f32x2*)(ws + WS_ABAR))[pidx] = (f32x2){abx, aby};
            float px = abx, py = aby;
#pragma unroll
            for (int s = 0; s < 6; ++s) { const float nx = px * px - py * py, ny = 2.0f * px * py; px = nx; py = ny; }
            ((f32x2*)(ws + WS_APOW))[pidx] = (f32x2){px, py};
            f16* bm = (f16*)(ws + WS_BMAT) + (size_t)ldg * 2048 + (2 * lane) * 16;
            const float* br = p.b_re + (size_t)pidx * 16; const float* bi = p.b_im + (size_t)pidx * 16;
#pragma unroll
            for (int ch = 0; ch < 16; ++ch) { const float r = br[ch], i = bi[ch]; bm[ch] = (f16)(cx * r - cy * i); bm[16 + ch] = (f16)(cx * i + cy * r); }
            f16* cm = (f16*)(ws + WS_CMAT) + (size_t)ldg * 2048 + 2 * lane;
#pragma unroll
            for (int h = 0; h < 16; ++h) { const float r = p.c_re[((size_t)ldg * 16 + h) * 64 + lane], i = p.c_im[((size_t)ldg * 16 + h) * 64 + lane];
                h2 v; v[0] = (f16)r; v[1] = (f16)(-i); *(h2*)(cm + h * 128) = v; }
        } else {
            const int t = it - 128, layer = t / 1088, r = t % 1088;
            LAS f16* tile = (LAS f16*)lds;
            if (r < 768) transpose_tile(p.w_in + (size_t)layer * 2048 * 6144, 6144, (f16*)(ws + WS_WIN) + (size_t)layer * 6144 * 2048, 2048, r / 24, r % 24, tile);
            else if (r < 1024) { const int q = r - 768; transpose_tile(p.w_out + (size_t)layer * 2048 * 2048, 2048, (f16*)(ws + WS_WOUT) + (size_t)layer * 2048 * 2048, 2048, q / 8, q % 8, tile); }
            else { const int q = r - 1024; transpose_tile(p.w_glu + (size_t)layer * 1024 * 1024, 1024, (f16*)(ws + WS_WGLU) + (size_t)layer * 1024 * 1024, 1024, q / 4, q % 4, tile); }
        }
    }
}

__device__ void phase_modulate0(const Params& p) {
    int tid = threadIdx.x; asm volatile("" : "+v"(tid));
    const int wid = __builtin_amdgcn_readfirstlane(tid >> 6), lane = tid & 63;
    const float* mod = (const float*)(p.ws + WS_MOD);
    f16* A = (f16*)(p.ws + WS_AO);
    for (int T = blockIdx.x * 8 + wid; T < NTOK; T += gridDim.x * 8) {
        const float* src = T < NCTX ? p.ctx + (size_t)T * D : p.x + (size_t)(T - NCTX) * D;
        const float* md = mod + (T < NCTX ? 6144 : 0);
        f32x4 v[8];
#pragma unroll
        for (int i = 0; i < 4; ++i) { v[2 * i] = *(const f32x4*)(src + 8 * lane + 512 * i); v[2 * i + 1] = *(const f32x4*)(src + 8 * lane + 512 * i + 4); }
        float s = 0.f;
#pragma unroll
        for (int i = 0; i < 8; ++i) s += (v[i][0] + v[i][1]) + (v[i][2] + v[i][3]);
        const float mu = wave_sum(s) * (1.0f / D);
        float q = 0.f;
#pragma unroll
        for (int i = 0; i < 8; ++i) { const f32x4 d = v[i] - mu; q += (d[0] * d[0] + d[1] * d[1]) + (d[2] * d[2] + d[3] * d[3]); }
        const float rstd = rsqrtf(wave_sum(q) * (1.0f / D) + LN_EPS);
#pragma unroll
        for (int i = 0; i < 4; ++i) { const int col = 8 * lane + 512 * i;
            const f32x4 s0 = *(const f32x4*)(md + 2048 + col), s1 = *(const f32x4*)(md + 2048 + col + 4), h0 = *(const f32x4*)(md + col), h1 = *(const f32x4*)(md + col + 4);
            const f32x4 o0 = (v[2 * i] - mu) * rstd * (1.0f + s0) + h0, o1 = (v[2 * i + 1] - mu) * rstd * (1.0f + s1) + h1;
            *(h8*)(A + (size_t)T * D + col) = pack8(o0, o1); }
    }
}
__device__ void phase_postnorm(const Params& p, int layer) {
    int tid = threadIdx.x; asm volatile("" : "+v"(tid));
    const int wid = __builtin_amdgcn_readfirstlane(tid >> 6), lane = tid & 63;
    const bool has_next = layer == 0;
    const float* mod = (const float*)(p.ws + WS_MOD) + (size_t)(layer + 1) * 2 * 6144;
    const float* lg = p.ln_g + layer * D; const float* lb = p.ln_b + layer * D;
    f16* A = (f16*)(p.ws + WS_AO);
    const int T0 = has_next ? 0 : NCTX;
    for (int T = T0 + blockIdx.x * 8 + wid; T < NTOK; T += gridDim.x * 8) {
        float* row = T < NCTX ? (float*)(p.ws + WS_CTXV) + (size_t)T * D : p.out + (size_t)(T - NCTX) * D;
        float* dst = T < NCTX ? (float*)(p.ws + WS_CTXN) + (size_t)T * D : row;
        f32x4 v[8];
#pragma unroll
        for (int i = 0; i < 4; ++i) { v[2 * i] = *(const f32x4*)(row + 8 * lane + 512 * i); v[2 * i + 1] = *(const f32x4*)(row + 8 * lane + 512 * i + 4); }
        float s = 0.f;
#pragma unroll
        for (int i = 0; i < 8; ++i) s += (v[i][0] + v[i][1]) + (v[i][2] + v[i][3]);
        const float mu = wave_sum(s) * (1.0f / D);
        float q = 0.f;
#pragma unroll
        for (int i = 0; i < 8; ++i) { const f32x4 d = v[i] - mu; q += (d[0] * d[0] + d[1] * d[1]) + (d[2] * d[2] + d[3] * d[3]); }
        const float rstd = rsqrtf(wave_sum(q) * (1.0f / D) + LN_EPS);
        float s2 = 0.f;
#pragma unroll
        for (int i = 0; i < 4; ++i) { const int col = 8 * lane + 512 * i;
            const f32x4 g0 = *(const f32x4*)(lg + col), g1 = *(const f32x4*)(lg + col + 4), b0 = *(const f32x4*)(lb + col), b1 = *(const f32x4*)(lb + col + 4);
            v[2 * i] = (v[2 * i] - mu) * rstd * g0 + b0; v[2 * i + 1] = (v[2 * i + 1] - mu) * rstd * g1 + b1;
            *(f32x4*)(dst + col) = v[2 * i]; *(f32x4*)(dst + col + 4) = v[2 * i + 1];
            s2 += (v[2 * i][0] + v[2 * i][1]) + (v[2 * i][2] + v[2 * i][3]) + (v[2 * i + 1][0] + v[2 * i + 1][1]) + (v[2 * i + 1][2] + v[2 * i + 1][3]); }
        if (has_next) {
            const float* md = mod + (T < NCTX ? 6144 : 0);
            const float mu2 = wave_sum(s2) * (1.0f / D);
            float q2 = 0.f;
#pragma unroll
            for (int i = 0; i < 8; ++i) { const f32x4 d = v[i] - mu2; q2 += (d[0] * d[0] + d[1] * d[1]) + (d[2] * d[2] + d[3] * d[3]); }
            const float rstd2 = rsqrtf(wave_sum(q2) * (1.0f / D) + LN_EPS);
#pragma unroll
            for (int i = 0; i < 4; ++i) { const int col = 8 * lane + 512 * i;
                const f32x4 s0 = *(const f32x4*)(md + 2048 + col), s1 = *(const f32x4*)(md + 2048 + col + 4), h0 = *(const f32x4*)(md + col), h1 = *(const f32x4*)(md + col + 4);
                const f32x4 o0 = (v[2 * i] - mu2) * rstd2 * (1.0f + s0) + h0, o1 = (v[2 * i + 1] - mu2) * rstd2 * (1.0f + s1) + h1;
                *(h8*)(A + (size_t)T * D + col) = pack8(o0, o1); }
        }
    }
}

__device__ void phase_conv(const Params& p, int layer) {
    const f16* P = (const f16*)(p.ws + WS_P); f16* O = (f16*)(p.ws + WS_AO);
    const float* cw = p.conv_w + layer * 3 * 1024; const float* cb = p.conv_b + layer * 1024;
    int tid = threadIdx.x; asm volatile("" : "+v"(tid));
    for (int idx = (layer == 0 ? 0 : NCTX * 128) + blockIdx.x * NTHR + tid; idx < NTOK * 128; idx += gridDim.x * NTHR) {
        const int T = idx >> 7, j = (idx & 127) * 8;
        const bool hl = T < NCTX ? (T > 0) : ((T & 63) != 0), hr = T < NCTX ? (T < NCTX - 1) : ((T & 63) != 63);
        const f16* pr = P + (size_t)T * DIN;
        const h8 v1 = *(const h8*)(pr + 2048 + j), c1 = *(const h8*)(pr + 4096 + j), bg = *(const h8*)(pr + 3072 + j), zc = *(const h8*)(pr + 5120 + j);
        h8 v0 = v1, c0 = c1, v2 = v1, c2 = c1;
        if (hl) { v0 = *(const h8*)(pr - DIN + 2048 + j); c0 = *(const h8*)(pr - DIN + 4096 + j); }
        if (hr) { v2 = *(const h8*)(pr + DIN + 2048 + j); c2 = *(const h8*)(pr + DIN + 4096 + j); }
        const f32x4 w0a = *(const f32x4*)(cw + j), w0b = *(const f32x4*)(cw + j + 4), w1a = *(const f32x4*)(cw + 1024 + j), w1b = *(const f32x4*)(cw + 1024 + j + 4),
            w2a = *(const f32x4*)(cw + 2048 + j), w2b = *(const f32x4*)(cw + 2048 + j + 4), ba = *(const f32x4*)(cb + j), bb = *(const f32x4*)(cb + j + 4);
        h8 o;
#pragma unroll
        for (int e = 0; e < 8; ++e) {
            const float w0 = e < 4 ? w0a[e & 3] : w0b[e & 3], w1 = e < 4 ? w1a[e & 3] : w1b[e & 3], w2 = e < 4 ? w2a[e & 3] : w2b[e & 3], b = e < 4 ? ba[e & 3] : bb[e & 3];
            const float sl = hl ? (float)c0[e] * (float)v0[e] : 0.f, sm = (float)c1[e] * (float)v1[e], sr = hr ? (float)c2[e] * (float)v2[e] : 0.f;
            const float conv = w0 * sl + w1 * sm + w2 * sr + b;
            o[e] = (f16)((float)bg[e] * conv * silu_f((float)zc[e]));
        }
        *(h8*)(O + (size_t)T * D + 1024 + j) = o;
    }
}

#define WAVE_LDS_SYNC() do { asm volatile("" ::: "memory"); __builtin_amdgcn_wave_barrier(); asm volatile("" ::: "memory"); } while (0)
template <bool PASS2>
__device__ __forceinline__ void s5_scan_dir(const unsigned char* ws, const f16* P, int layer, int c, int g, int dir, const float* log_dt, LAS float* bu, LAS unsigned* Hb, int lane, f32x4 (&yacc)[4]) {
    const int fr = lane & 15, fq = lane >> 4;
    const int ldg = (layer * 2 + dir) * 64 + g;
    const int q = dir == 0 ? c : (c < 4 ? 3 - c : 135 - c);
    const f32x2 a = ((const f32x2*)(ws + WS_ABAR))[ldg * 64 + lane];
    const float dt = __expf(log_dt[ldg]);
    h4 bm[8], uf[4];
#pragma unroll
    for (int ss = 0; ss < 4; ++ss) { const int sc = dir ? 3 - ss : ss; uf[ss] = *(const h4*)(P + (size_t)(c * 64 + sc * 16 + fr) * DIN + g * 16 + 4 * fq); }
#pragma unroll
    for (int t = 0; t < 8; ++t) bm[t] = *(const h4*)((const f16*)(ws + WS_BMAT) + (size_t)ldg * 2048 + (16 * t + fr) * 16 + 4 * fq);
    h8 cm[4];
    f32x2 h = {0.f, 0.f};
    if (PASS2) {
#pragma unroll
        for (int kk = 0; kk < 4; ++kk) cm[kk] = *(const h8*)((const f16*)(ws + WS_CMAT) + (size_t)ldg * 2048 + fr * 128 + 32 * kk + 8 * fq);
        h = ((const f32x2*)(ws + WS_SCAR))[((size_t)(dir * NCH + q) * 64 + g) * 64 + lane];
    }
    const f32x2 aa = {a[0], a[0]}, ab = {-a[1], a[1]};
#pragma unroll
    for (int ss = 0; ss < 4; ++ss) {
        const int sc = dir ? 3 - ss : ss;
        f32x4 r[8];
#pragma unroll
        for (int t = 0; t < 8; ++t) r[t] = __builtin_amdgcn_mfma_f32_16x16x16f16(bm[t], uf[ss], (f32x4){0.f, 0.f, 0.f, 0.f}, 0, 0, 0);
#pragma unroll
        for (int t = 0; t < 8; ++t) *(LAS f32x4*)(bu + fr * 132 + 16 * t + 4 * fq) = r[t];
        WAVE_LDS_SYNC();
        f32x2 b[16];
#pragma unroll
        for (int i = 0; i < 16; ++i) b[i] = *(const LAS f32x2*)(bu + (dir ? 15 - i : i) * 132 + 2 * lane);
#pragma unroll
        for (int i = 0; i < 16; ++i) {
            const int t = dir ? 15 - i : i;
            const f32x2 hs = {h[1], h[0]};
            h = aa * h + (ab * hs + b[i]);
            if (PASS2) { h2 hv; hv[0] = (f16)h[0]; hv[1] = (f16)h[1]; Hb[t * 68 + lane] = __builtin_bit_cast(unsigned, hv); }
        }
        WAVE_LDS_SYNC();
        if (PASS2) {
            f32x4 acc = {0.f, 0.f, 0.f, 0.f};
#pragma unroll
            for (int kk = 0; kk < 4; ++kk) { const h8 af = *(const LAS h8*)((LAS unsigned char*)Hb + fr * 272 + (32 * kk + 8 * fq) * 2);
                acc = __builtin_amdgcn_mfma_f32_16x16x32_f16(af, cm[kk], acc, 0, 0, 0); }
            yacc[sc] += dt * acc;
        }
    }
    if (!PASS2) ((f32x2*)(ws + WS_EST))[((size_t)(dir * NCH + q) * 64 + g) * 64 + lane] = h;
}
template <bool PASS2>
__device__ void phase_s5(const Params& p, int layer, LAS unsigned char* lds, int c0) {
    int tid = threadIdx.x; asm volatile("" : "+v"(tid));
    const int wid = __builtin_amdgcn_readfirstlane(tid >> 6), lane = tid & 63;
    const int fr = lane & 15, fq = lane >> 4;
    unsigned char* ws = p.ws;
    const f16* P = (const f16*)(ws + WS_P);
    LAS float* bu = (LAS float*)(lds + wid * 12800);
    LAS unsigned* Hb = (LAS unsigned*)(lds + wid * 12800 + 8448);
    const int gw = blockIdx.x * 8 + wid, nw = gridDim.x * 8;
    f32x4 yacc[4];
    if (!PASS2) {
        for (int it = gw; it < NCH * 128; it += nw) {
            const int dir = it & 1, g = (it >> 1) & 63, c = it >> 7;
            s5_scan_dir<false>(ws, P, layer, c, g, dir, p.log_dt, bu, Hb, lane, yacc);
        }
    } else {
        for (int it = gw; it < (NCH - c0) * 64; it += nw) {
            const int g = it & 63, c = c0 + (it >> 6);
#pragma unroll
            for (int i = 0; i < 4; ++i) yacc[i] = (f32x4){0.f, 0.f, 0.f, 0.f};
            s5_scan_dir<true>(ws, P, layer, c, g, 0, p.log_dt, bu, Hb, lane, yacc);
            s5_scan_dir<true>(ws, P, layer, c, g, 1, p.log_dt, bu, Hb, lane, yacc);
            WAVE_LDS_SYNC();
#pragma unroll
            for (int sc = 0; sc < 4; ++sc)
#pragma unroll
                for (int r = 0; r < 4; ++r) bu[(sc * 16 + 4 * fq + r) * 20 + fr] = yacc[sc][r];
            WAVE_LDS_SYNC();
            const int T = c * 64 + lane, ch = g * 16;
            const h8 u0 = *(const h8*)(P + (size_t)T * DIN + ch), u1 = *(const h8*)(P + (size_t)T * DIN + ch + 8);
            const float* dsk = p.s5_d + layer * DS5 + ch;
            h8 o0, o1;
#pragma unroll
            for (int j4 = 0; j4 < 4; ++j4) { const f32x4 yv = *(const LAS f32x4*)(bu + lane * 20 + 4 * j4);
#pragma unroll
                for (int e = 0; e < 4; ++e) { const int j = 4 * j4 + e; const float uu = j < 8 ? (float)u0[j & 7] : (float)u1[j & 7];
                    const float gv = gelu_tanh_f(dsk[j] * uu + yv[e]); if (j < 8) o0[j & 7] = (f16)gv; else o1[j & 7] = (f16)gv; } }
            f16* gp = (f16*)(ws + WS_G) + (size_t)T * DS5 + ch;
            *(h8*)gp = o0; *(h8*)(gp + 8) = o1;
            WAVE_LDS_SYNC();
        }
    }
}
__device__ void phase_carry(const Params& p, int layer) {
    int tid = threadIdx.x; asm volatile("" : "+v"(tid));
    const int gt = blockIdx.x * NTHR + tid;
    if (gt >= 2 * 4096) return;
    const int dir = gt >> 12, gp = gt & 4095;
    const f32x2 a = ((const f32x2*)(p.ws + WS_APOW))[(layer * 2 + dir) * 4096 + gp];
    const f32x2* E = (const f32x2*)(p.ws + WS_EST) + (size_t)dir * NCH * 4096 + gp;
    f32x2* S = (f32x2*)(p.ws + WS_SCAR) + (size_t)dir * NCH * 4096 + gp;
    float sr = 0.f, si = 0.f;
#pragma unroll 1
    for (int q0 = 0; q0 < NCH; q0 += 33) {
        f32x2 e[33];
#pragma unroll
        for (int j = 0; j < 33; ++j) e[j] = E[(size_t)(q0 + j) * 4096];
#pragma unroll
        for (int j = 0; j < 33; ++j) { S[(size_t)(q0 + j) * 4096] = (f32x2){sr, si};
            const float nr = a[0] * sr - a[1] * si + e[j][0], ni = a[0] * si + a[1] * sr + e[j][1]; sr = nr; si = ni; }
    }
}

__global__ void __launch_bounds__(NTHR, 2) fwd_megakernel(Params p) {
    extern __shared__ __attribute__((aligned(16))) unsigned char lds_raw[];
    LAS unsigned char* lds = (LAS unsigned char*)lds_raw;
    cg::grid_group grid = cg::this_grid();
    if (p.ph_lo > 1000) grid.sync();
    volatile LAS unsigned* xst = (volatile LAS unsigned*)(lds + LDS_BYTES - 16);
    if (threadIdx.x < 4) xst[threadIdx.x] = 0u;
    __syncthreads();
    const XcdBarrier xbar = xcd_barrier_post((unsigned*)(p.ws + WS_CTL), xst);
#define GRID_SYNC() xcd_barrier(xbar)
    unsigned char* ws = p.ws;
    const int lo = p.ph_lo, hi = p.ph_hi;
    int ph = 0;
#ifndef PROBE_DUP
#define PROBE_DUP 0
#endif
#define PHASE_BEGIN(kind) if (ph >= lo && ph < hi) { for (int rep = 0; rep < (((PROBE_DUP) & (kind)) ? 2 : 1); ++rep) { if (rep) GRID_SYNC();
#define PHASE_END   } if (ph + 1 < hi) GRID_SYNC(); } ++ph;
    PHASE_BEGIN(1) phase_prologue(p, lds); PHASE_END
    for (int layer = 0; layer < 2; ++layer) {
        const float* modl = (const float*)(ws + WS_MOD) + (size_t)layer * 2 * 6144;
        if (layer == 0) { PHASE_BEGIN(2) phase_modulate0(p); PHASE_END }
        PHASE_BEGIN(4) {
            pg8::Gemm g{(const f16*)(ws + WS_AO), (const f16*)(ws + WS_WIN) + (size_t)layer * 6144 * 2048, NTOK, DIN, D};
            pg8::StaticOrder S; if (layer == 0) S.init(NTOK, DIN, gridDim.x, blockIdx.x, 0, 0); else S.init(NLAT, DIN, gridDim.x, blockIdx.x, 1, 4);
            EpiP E{(f16*)(ws + WS_P)};
            pg8::gemm_phase<EpiP>(lds, g, S, E);
        } PHASE_END
        PHASE_BEGIN(8) phase_s5<false>(p, layer, lds, 0); phase_conv(p, layer); PHASE_END
        PHASE_BEGIN(16) phase_carry(p, layer); PHASE_END
        PHASE_BEGIN(32) phase_s5<true>(p, layer, lds, layer == 0 ? 0 : 4); PHASE_END
        PHASE_BEGIN(64) {
            pg8::Gemm g{(const f16*)(ws + WS_G), (const f16*)(ws + WS_WGLU) + (size_t)layer * 1024 * 1024, NTOK, DS5, DS5};
            pg8::StaticOrder S; if (layer == 0) S.init(NTOK, DS5, gridDim.x, blockIdx.x, 0, 0); else S.init(NLAT, DS5, gridDim.x, blockIdx.x, 1, 0);
            EpiGlu E{(const f16*)(ws + WS_G), (const f16*)(ws + WS_P), p.b_glu + layer * DS5, (f16*)(ws + WS_AO)};
            pg8::gemm_phase<EpiGlu>(lds, g, S, E);
        } PHASE_END
        PHASE_BEGIN(layer == 0 ? 128 : 0) {
            pg8::Gemm g{(const f16*)(ws + WS_AO), (const f16*)(ws + WS_WOUT) + (size_t)layer * 2048 * 2048, NTOK, D, D};
            pg8::StaticOrder S; if (layer == 0) S.init(NTOK, D, gridDim.x, blockIdx.x, 0, 0); else S.init(NLAT, D, gridDim.x, blockIdx.x, 1, 0);
            EpiOut E{layer == 0 ? p.x : p.out, layer == 0 ? p.ctx : (const float*)(ws + WS_CTXN), p.out, (float*)(ws + WS_CTXV), modl + 4096, modl + 6144 + 4096};
            pg8::gemm_phase<EpiOut>(lds, g, S, E);
        } PHASE_END
        PHASE_BEGIN(0) phase_postnorm(p, layer); PHASE_END
    }
#undef PHASE_BEGIN
#undef PHASE_END
}
constexpr int N_PHASES = 16;

extern "C" void kernel_launch(void* const* d_in, const int* in_sizes, int n_in, void* d_out, int out_size, void* d_ws, size_t ws_size, hipStream_t stream) {
    static int grid_blocks = 0;
    if (!grid_blocks) {
        int dev = 0, cus = 0, per_cu = 0;
        hipGetDevice(&dev);
        hipDeviceGetAttribute(&cus, hipDeviceAttributeMultiprocessorCount, dev);
        hipFuncSetAttribute((const void*)fwd_megakernel, hipFuncAttributeMaxDynamicSharedMemorySize, LDS_BYTES);
        hipOccupancyMaxActiveBlocksPerMultiprocessor(&per_cu, (const void*)fwd_megakernel, NTHR, LDS_BYTES);
        if (per_cu < 1) { fprintf(stderr, "occupancy query says %d blocks/CU\n", per_cu); per_cu = 1; }
        grid_blocks = cus;
        if (ws_size < WS_END) fprintf(stderr, "workspace too small: %zu < %zu\n", ws_size, (size_t)WS_END);
    }
    (void)hipMemsetAsync((char*)d_ws + WS_CTL, 0, 16384, stream);
    Params p{};
    const float** pp = (const float**)&p;
    for (int i = 0; i < 22; ++i) pp[i] = (const float*)d_in[i];
    p.out = (float*)d_out; p.ws = (unsigned char*)d_ws;
#if N_LAUNCH_SPLIT
    for (int ph = 0; ph < N_PHASES; ++ph) { p.ph_lo = ph; p.ph_hi = ph + 1; hipLaunchKernelGGL(fwd_megakernel, dim3(grid_blocks), dim3(NTHR), LDS_BYTES, stream, p); }
#else
    p.ph_lo = 0; p.ph_hi = N_PHASES;
    void* args[] = {&p};
    hipError_t e = hipLaunchCooperativeKernel((const void*)fwd_megakernel, dim3(grid_blocks), dim3(NTHR), args, LDS_BYTES, stream);
    if (e != hipSuccess) fprintf(stderr, "cooperative launch failed: %s (grid %d)\n", hipGetErrorString(e), grid_blocks);
#endif
}
```
